# Optimizing an MI355X kernel written in HIP

```python
import math
import jax, jax.numpy as jnp
from jax import lax
import numpy as np

D_MODEL = 2048
BATCH = 4
SEQ = 2048
DEPTH = 4

N_MIXERS = 3
PLE_DIM = 256
D_FF = 5632
A_HEADS = 8
A_HEAD_DIM = 128
B_HEADS = 16
B_HEAD_DIM = 128
MOBA_BLOCK = 256
MOBA_TOPK = 3
MOBA_Q_BLOCK = 16
C_HEADS = 16
C_KV_HEADS = 4
C_HEAD_DIM = 128
IDX_HEADS = 16
IDX_DIM = 64
DSA_TOPK_MAX = 256
C_Q = C_HEADS * C_HEAD_DIM
C_KV = C_KV_HEADS * C_HEAD_DIM
C_IQ = IDX_HEADS * IDX_DIM
C_IN_COLS = C_Q + 2 * C_KV + C_IQ + IDX_DIM + IDX_HEADS

Q_BLOCK = 128
LN_EPS = 1e-5
RMS_EPS = 1e-6
ALPHA = (2.0 * DEPTH) ** 0.25
BETA = (8.0 * DEPTH) ** -0.25
N_A = (DEPTH + 2) // 3
N_B = (DEPTH + 1) // 3
N_C = DEPTH // 3

kernel_name = 'hybrid_diff_moba_dsa_macaron_deepnorm'


def alibi_slopes(n):
    return jnp.asarray(2.0 ** (-8.0 * np.arange(1, n + 1, dtype=np.float32) / n), dtype=jnp.float32)


def layer_norm(x, g, b):
    xf = x.astype(jnp.float32)
    mu = jnp.mean(xf, -1, keepdims=True)
    var = jnp.mean(jnp.square(xf - mu), -1, keepdims=True)
    y = (xf - mu) * lax.rsqrt(var + LN_EPS) * g.astype(jnp.float32) + b.astype(jnp.float32)
    return y.astype(x.dtype)


def swiglu_ffn(x, w_in, w_out):
    gate, up = jnp.split(x @ w_in, 2, axis=-1)
    return (jax.nn.silu(gate) * up) @ w_out


def diff_attention(x, w_in, w_out, lam_q1, lam_k1, lam_q2, lam_k2, subln_g, lambda_init):
    B, S, _ = x.shape
    H, d = A_HEADS, A_HEAD_DIM
    f32 = jnp.float32
    q, k, v = jnp.split(x @ w_in, 3, axis=-1)
    q = q.reshape(B, S, H, 2, d)
    k = k.reshape(B, S, H, 2, d)
    v = v.reshape(B, S, H, 2 * d)
    lam = (jnp.exp(jnp.sum(lam_q1.astype(f32) * lam_k1.astype(f32)))
           - jnp.exp(jnp.sum(lam_q2.astype(f32) * lam_k2.astype(f32))) + lambda_init)
    slopes = alibi_slopes(H)[:, None, None, None]
    key_pos = jnp.arange(S)
    nqb = S // Q_BLOCK
    q_blocks = q.reshape(B, nqb, Q_BLOCK, H, 2, d).transpose(1, 0, 2, 3, 4, 5)
    starts = jnp.arange(nqb) * Q_BLOCK
    scale = d ** -0.5

    def one_block(args):
        qb, start = args
        t = start + jnp.arange(Q_BLOCK)
        dist = (t[:, None] - key_pos[None, :]).astype(f32)
        s = jnp.einsum('bqhmd,bkhmd->bhmqk', qb, k).astype(f32) * scale
        s = jnp.where(dist >= 0, s - slopes * dist, -jnp.inf)
        pr = jax.nn.softmax(s, axis=-1)
        a = pr[:, :, 0] - lam * pr[:, :, 1]
        return jnp.einsum('bhqk,bkhe->bqhe', a.astype(v.dtype), v)

    o = lax.map(one_block, (q_blocks, starts))
    o = o.transpose(1, 0, 2, 3, 4).reshape(B, S, H, 2 * d).astype(f32)
    o = o * lax.rsqrt(jnp.mean(o * o, -1, keepdims=True) + RMS_EPS) * subln_g.astype(f32) * (1.0 - lambda_init)
    return o.reshape(B, S, H * 2 * d).astype(x.dtype) @ w_out


def moba_attention(x, w_in, w_out):
    B, S, _ = x.shape
    H, d, BS, QC = B_HEADS, B_HEAD_DIM, MOBA_BLOCK, MOBA_Q_BLOCK
    f32 = jnp.float32
    q, k, v = jnp.split(x @ w_in, 3, axis=-1)
    q = q.reshape(B, S, H, d)
    k = k.reshape(B, S, H, d)
    v = v.reshape(B, S, H, d)
    nb = -(-S // BS)
    pad = nb * BS - S
    kp = jnp.pad(k, ((0, 0), (0, pad), (0, 0), (0, 0)))
    vp = jnp.pad(v, ((0, 0), (0, pad), (0, 0), (0, 0)))
    k_blocks = kp.reshape(B, nb, BS, H, d).transpose(0, 3, 1, 2, 4)
    v_blocks = vp.reshape(B, nb, BS, H, d).transpose(0, 3, 1, 2, 4)
    k_mean = jnp.mean(k_blocks.astype(f32), axis=3)
    n_sel = min(MOBA_TOPK, nb - 1)
    slopes = alibi_slopes(H)
    in_block = jnp.arange(BS)
    scale = d ** -0.5
    gather_blocks = jax.vmap(jax.vmap(lambda blocks, ids: blocks[ids]))
    nqc = S // QC
    q_chunks = q.reshape(B, nqc, QC, H, d).transpose(1, 0, 2, 3, 4)
    starts = jnp.arange(nqc) * QC

    def one_chunk(args):
        qc, start = args
        t = start + jnp.arange(QC)
        own = start // BS
        k_own = lax.dynamic_slice_in_dim(kp, own * BS, BS, axis=1)
        v_own = lax.dynamic_slice_in_dim(vp, own * BS, BS, axis=1)
        dist_own = (t[:, None] - (own * BS + in_block)[None, :]).astype(f32)
        s_own = jnp.einsum('bqhd,bkhd->bhqk', qc, k_own).astype(f32) * scale
        s_own = jnp.where(dist_own >= 0, s_own - slopes[:, None, None] * dist_own, -jnp.inf)
        if n_sel == 0:
            p_own = jax.nn.softmax(s_own, axis=-1).astype(v.dtype)
            return jnp.einsum('bhqk,bkhd->bqhd', p_own, v_own)
        gate = jnp.einsum('bqhd,bhnd->bhqn', qc.astype(f32), k_mean)
        gate = jnp.where(jnp.arange(nb) < own, gate, -jnp.inf)
        _, sel = lax.top_k(gate, n_sel)
        valid = sel < own
        k_sel = gather_blocks(k_blocks, sel)
        v_sel = gather_blocks(v_blocks, sel)
        dist_sel = (t[None, None, :, None, None] - (sel[..., None] * BS + in_block)).astype(f32)
        s_sel = jnp.einsum('bqhd,bhqnkd->bhqnk', qc, k_sel).astype(f32) * scale
        s_sel = jnp.where(valid[..., None], s_sel - slopes[None, :, None, None, None] * dist_sel, -jnp.inf)
        n_g = n_sel * BS
        pr = jax.nn.softmax(jnp.concatenate([s_sel.reshape(B, H, QC, n_g), s_own], axis=-1), axis=-1)
        p_sel = pr[..., :n_g].reshape(B, H, QC, n_sel, BS).astype(v.dtype)
        p_own = pr[..., n_g:].astype(v.dtype)
        return (jnp.einsum('bhqnk,bhqnkd->bqhd', p_sel, v_sel)
                + jnp.einsum('bhqk,bkhd->bqhd', p_own, v_own))

    o = lax.map(one_chunk, (q_chunks, starts))
    o = o.transpose(1, 0, 2, 3, 4).reshape(B, S, H * d)
    return o @ w_out


def dsa_attention(x, w_in, w_out):
    B, S, _ = x.shape
    H, G, d = C_HEADS, C_KV_HEADS, C_HEAD_DIM
    R = H // G
    f32 = jnp.float32
    cuts = [C_Q, C_Q + C_KV, C_Q + 2 * C_KV, C_Q + 2 * C_KV + C_IQ, C_Q + 2 * C_KV + C_IQ + IDX_DIM]
    q, k, v, q_idx, k_idx, w_idx = jnp.split(x @ w_in, cuts, axis=-1)
    q = q.reshape(B, S, G, R, d)
    k = k.reshape(B, S, G, d)
    v = v.reshape(B, S, G, d)
    q_idx = q_idx.reshape(B, S, IDX_HEADS, IDX_DIM)
    k_idx = k_idx.astype(f32)
    w_idx = w_idx.astype(f32) * IDX_HEADS ** -0.5
    n_keep = min(DSA_TOPK_MAX, S // 4)
    slopes = alibi_slopes(H).reshape(G, R)
    key_pos = jnp.arange(S)
    scale = d ** -0.5
    gather_tokens = jax.vmap(lambda tokens, ids: tokens[ids])
    nqb = S // Q_BLOCK
    q_b = q.reshape(B, nqb, Q_BLOCK, G, R, d).transpose(1, 0, 2, 3, 4, 5)
    qi_b = q_idx.reshape(B, nqb, Q_BLOCK, IDX_HEADS, IDX_DIM).transpose(1, 0, 2, 3, 4)
    wi_b = w_idx.reshape(B, nqb, Q_BLOCK, IDX_HEADS).transpose(1, 0, 2, 3)
    starts = jnp.arange(nqb) * Q_BLOCK

    def one_block(args):
        qb, qib, wib, start = args
        t = start + jnp.arange(Q_BLOCK)
        dots = jnp.einsum('bqhe,bse->bqhs', qib.astype(f32), k_idx) * IDX_DIM ** -0.5
        score = jnp.einsum('bqh,bqhs->bqs', wib, jax.nn.relu(dots))
        score = jnp.where(key_pos[None, :] <= t[:, None], score, -jnp.inf)
        _, idx = lax.top_k(score, n_keep)
        valid = idx <= t[None, :, None]
        k_sel = gather_tokens(k, idx)
        v_sel = gather_tokens(v, idx)
        dist = (t[None, :, None] - idx).astype(f32)
        s = jnp.einsum('bqgrd,bqkgd->bgrqk', qb, k_sel).astype(f32) * scale
        s = s - slopes[None, :, :, None, None] * dist[:, None, None]
        s = jnp.where(valid[:, None, None], s, -jnp.inf)
        pr = jax.nn.softmax(s, axis=-1).astype(v.dtype)
        return jnp.einsum('bgrqk,bqkgd->bqgrd', pr, v_sel)

    o = lax.map(one_block, (q_b, qi_b, wi_b, starts))
    o = o.transpose(1, 0, 2, 3, 4, 5).reshape(B, S, H * d)
    return o @ w_out


def per_layer_embedding(x, p_i, w_gate, w_proj):
    return jax.nn.sigmoid(x @ w_gate) * (p_i @ w_proj)


def setup_inputs(seed: int = 0) -> dict:
    key = jax.random.key(seed)
    ks = jax.random.split(key, 24)
    f32 = jnp.float32
    D, F = D_MODEL, D_FF
    nrm = lambda k, shape, s: jax.random.normal(k, shape, f32) * s
    return {
        'x': nrm(ks[0], (BATCH, SEQ, D), 1.0),
        'p': nrm(ks[1], (DEPTH, BATCH, SEQ, PLE_DIM), 1.0),
        'ffn1_w_in': nrm(ks[2], (DEPTH, D, 2 * F), D ** -0.5),
        'ffn1_w_out': nrm(ks[3], (DEPTH, F, D), F ** -0.5 * BETA),
        'ffn2_w_in': nrm(ks[4], (DEPTH, D, 2 * F), D ** -0.5),
        'ffn2_w_out': nrm(ks[5], (DEPTH, F, D), F ** -0.5 * BETA),
        'ln_g': 1.0 + nrm(ks[6], (DEPTH, 4, D), 0.02),
        'ln_b': nrm(ks[7], (DEPTH, 4, D), 0.02),
        'ple_w_gate': nrm(ks[8], (DEPTH, D, D), D ** -0.5),
        'ple_w_proj': nrm(ks[9], (DEPTH, PLE_DIM, D), PLE_DIM ** -0.5 * BETA),
        'a_w_in': nrm(ks[10], (N_A, D, 3 * D), D ** -0.5),
        'a_w_out': nrm(ks[11], (N_A, D, D), D ** -0.5 * BETA),
        'a_lam_q1': nrm(ks[12], (N_A, A_HEAD_DIM), 0.1),
        'a_lam_k1': nrm(ks[13], (N_A, A_HEAD_DIM), 0.1),
        'a_lam_q2': nrm(ks[14], (N_A, A_HEAD_DIM), 0.1),
        'a_lam_k2': nrm(ks[15], (N_A, A_HEAD_DIM), 0.1),
        'a_subln_g': 1.0 + nrm(ks[16], (N_A, 2 * A_HEAD_DIM), 0.02),
        'b_w_in': nrm(ks[17], (N_B, D, 3 * B_HEADS * B_HEAD_DIM), D ** -0.5),
        'b_w_out': nrm(ks[18], (N_B, B_HEADS * B_HEAD_DIM, D), (B_HEADS * B_HEAD_DIM) ** -0.5 * BETA),
        'c_w_in': nrm(ks[19], (N_C, D, C_IN_COLS), D ** -0.5),
        'c_w_out': nrm(ks[20], (N_C, C_Q, D), C_Q ** -0.5 * BETA),
    }


def reference(x, p, ffn1_w_in, ffn1_w_out, ffn2_w_in, ffn2_w_out, ln_g, ln_b,
              ple_w_gate, ple_w_proj, a_w_in, a_w_out, a_lam_q1, a_lam_k1, a_lam_q2,
              a_lam_k2, a_subln_g, b_w_in, b_w_out, c_w_in, c_w_out):
    for i in range(DEPTH):
        m, j = i % N_MIXERS, i // N_MIXERS
        x = layer_norm(ALPHA * x + 0.5 * swiglu_ffn(x, ffn1_w_in[i], ffn1_w_out[i]), ln_g[i, 0], ln_b[i, 0])
        if m == 0:
            lambda_init = 0.8 - 0.6 * math.exp(-0.3 * i)
            y = diff_attention(x, a_w_in[j], a_w_out[j], a_lam_q1[j], a_lam_k1[j],
                               a_lam_q2[j], a_lam_k2[j], a_subln_g[j], lambda_init)
        elif m == 1:
            y = moba_attention(x, b_w_in[j], b_w_out[j])
        else:
            y = dsa_attention(x, c_w_in[j], c_w_out[j])
        x = layer_norm(ALPHA * x + y, ln_g[i, 1], ln_b[i, 1])
        x = layer_norm(ALPHA * x + 0.5 * swiglu_ffn(x, ffn2_w_in[i], ffn2_w_out[i]), ln_g[i, 2], ln_b[i, 2])
        x = layer_norm(ALPHA * x + per_layer_embedding(x, p[i], ple_w_gate[i], ple_w_proj[i]), ln_g[i, 3], ln_b[i, 3])
    return x
```

```cpp
#include <hip/hip_runtime.h>
#include <cstdio>
#include <cstdint>
namespace pg8 {
#define PG8_LAS __attribute__((address_space(3)))
typedef unsigned short bf16_t;
typedef short bf16x8 __attribute__((ext_vector_type(8)));
typedef float f32x4 __attribute__((ext_vector_type(4)));
typedef unsigned u32x4 __attribute__((ext_vector_type(4)));
constexpr int BM = 256, BK = 64, HALF = 128, HTB = HALF * BK * 2  , STAGE_BYTES = 8 * HTB, NXCD = 8, WGM = 8;

__host__ __device__ __forceinline__ int lds_byte(int r, int c) { const int st = (r >> 4) * 2 + (c >> 5), rr = r & 15, cc = c & 31, ob = rr * 64 + cc * 2; return st * 1024 + (ob ^ (((ob >> 9) & 1) << 5)); }
__host__ __device__ __forceinline__ void stage_rc(int b, int& R, int& C) { const int st = b / 1024, sb = b % 1024, swz = sb ^ (((sb >> 9) & 1) << 5); R = (st >> 1) * 16 + swz / 64; C = (st & 1) * 32 + (swz % 64) / 2; }
__host__ __device__ __forceinline__ int perm32(int rho) { const int n = rho >> 4, i = rho & 15; return 8 * (i >> 2) + 4 * n + (i & 3); }

struct Unit { int pm, pn; };
struct Gemm { const bf16_t* A; const bf16_t* Bt; int M, N, K; };

struct StaticOrder {
    int nM, nN, nwg, G, c;
    __host__ __device__ void init(int M, int N, int G_, int c_) { nM = M / BM; nN = N / BM; nwg = nM * nN; G = G_; c = c_; }
    __host__ __device__ bool next(int i, Unit& u) const {
        const long L = (long)i * G + c; if (L >= nwg) return false;
        int wgid = (int)L; { const int q = nwg / NXCD, r = nwg % NXCD, xcd = wgid % NXCD, off = wgid / NXCD; wgid = (xcd < r ? xcd * (q + 1) : r * (q + 1) + (xcd - r) * q) + off; }
        const int nig = WGM * nN, gid = wgid / nig, fm = gid * WGM, gsz = (nM - fm) < WGM ? (nM - fm) : WGM;
        u.pm = fm + ((wgid % nig) % gsz); u.pn = (wgid % nig) / gsz; return true;
    }
    __device__ __forceinline__ void a_ready(const Unit&) const {}
    __device__ __forceinline__ void done(const Unit&) const {}
};

__device__ __forceinline__ unsigned cvt_pk_bf16(float lo, float hi) { unsigned r; asm volatile("v_cvt_pk_bf16_f32 %0, %1, %2" : "=v"(r) : "v"(lo), "v"(hi)); return r; }
typedef float f32x2 __attribute__((ext_vector_type(2)));
__device__ __forceinline__ f32x2 gelu_pk(f32x2 v) {
    const f32x2 av = __builtin_elementwise_abs(v), d = av * 0.2316418882f + 1.0f;
    f32x2 t; t.x = __builtin_amdgcn_rcpf(d.x); t.y = __builtin_amdgcn_rcpf(d.y);
    f32x2 q = t * 0.5307027145f + (-0.7265760135f); q = q * t + 0.7107068705f; q = q * t + (-0.142248368f); q = q * t + 0.127414796f; q = q * t;
    const f32x2 s = (v * v) * (-0.72134752044f);
    f32x2 e; e.x = __builtin_amdgcn_exp2f(s.x); e.y = __builtin_amdgcn_exp2f(s.y);
    const f32x2 m = v * (q * e), r = v - m;
    f32x2 o; o.x = v.x < 0.f ? m.x : r.x; o.y = v.y < 0.f ? m.y : r.y; return o;
}

template <int ACT  > struct EpiBf16 {
    static constexpr bool PERM = true, AFTER_DRAIN = false; static_assert(ACT == 0 || ACT == 1, "EpiBf16: ACT is 0 (none) or 1 (gelu_pk)");
    bf16_t* O; int ldc; const float* bias; int split_cols; size_t split_stride; float scale0;
    __device__ __forceinline__ void operator()(const f32x4 (&acc)[2][2][4][2], const Unit& u, int wr, int wc, int fr, int fq) const {
        const int row0 = u.pm * BM + wr * 64 + fr; int colt = u.pn * BM; bf16_t* base = O;
        float sc = 1.f; if (split_cols) { const int t = colt / split_cols; base += (size_t)t * split_stride; colt -= t * split_cols; if (t == 0) sc = scale0; }
        const int col0 = colt + wc * 32 + 8 * fq, bcol0 = u.pn * BM + wc * 32 + 8 * fq;
        f32x4 bv[2][2];
#pragma unroll
        for (int bj = 0; bj < 2; ++bj)
#pragma unroll
            for (int n = 0; n < 2; ++n) bv[bj][n] = bias ? *(const f32x4*)(bias + bcol0 + bj * HALF + 4 * n) : (f32x4){0.f, 0.f, 0.f, 0.f};
#pragma unroll
        for (int ai = 0; ai < 2; ++ai)
#pragma unroll
            for (int m = 0; m < 4; ++m) { bf16_t* rowp = base + (size_t)(row0 + ai * HALF + m * 16) * ldc + col0;
#pragma unroll
                for (int bj = 0; bj < 2; ++bj) { f32x4 v0 = acc[ai][bj][m][0] + bv[bj][0], v1 = acc[ai][bj][m][1] + bv[bj][1];
                    if (ACT == 1) { f32x2 a = gelu_pk((f32x2){v0[0], v0[1]}), b = gelu_pk((f32x2){v0[2], v0[3]}), c = gelu_pk((f32x2){v1[0], v1[1]}), d = gelu_pk((f32x2){v1[2], v1[3]});
                        v0 = (f32x4){a.x, a.y, b.x, b.y}; v1 = (f32x4){c.x, c.y, d.x, d.y}; }
                    v0 = v0 * sc; v1 = v1 * sc; u32x4 w; w.x = cvt_pk_bf16(v0[0], v0[1]); w.y = cvt_pk_bf16(v0[2], v0[3]); w.z = cvt_pk_bf16(v1[0], v1[1]); w.w = cvt_pk_bf16(v1[2], v1[3]);
                    *(u32x4*)(rowp + bj * HALF) = w; } }
    }
};

struct EpiF32 {
    static constexpr bool PERM = false, AFTER_DRAIN = false;
    float* C; int ldc;
    __device__ __forceinline__ void operator()(const f32x4 (&acc)[2][2][4][2], const Unit& u, int wr, int wc, int fr, int fq) const {
        const int row0 = u.pm * BM + wr * 64 + fr, col0 = u.pn * BM + wc * 32 + 4 * fq;
#pragma unroll
        for (int ai = 0; ai < 2; ++ai)
#pragma unroll
            for (int m = 0; m < 4; ++m) { float* rowp = C + (size_t)(row0 + ai * HALF + m * 16) * ldc + col0;
#pragma unroll
                for (int bj = 0; bj < 2; ++bj)
#pragma unroll
                    for (int n = 0; n < 2; ++n) *(f32x4*)(rowp + bj * HALF + n * 16) = acc[ai][bj][m][n]; }
    }
};
struct EpiZ {
    static constexpr bool PERM = false, AFTER_DRAIN = false;
    const float* resid; float* Z; int ldc; float alpha, s;
    __device__ __forceinline__ void operator()(const f32x4 (&acc)[2][2][4][2], const Unit& u, int wr, int wc, int fr, int fq) const {
        const int row0 = u.pm * BM + wr * 64 + fr, col0 = u.pn * BM + wc * 32 + 4 * fq;
#pragma unroll
        for (int ai = 0; ai < 2; ++ai)
#pragma unroll
            for (int m = 0; m < 4; ++m) { const size_t off = (size_t)(row0 + ai * HALF + m * 16) * ldc + col0;
#pragma unroll
                for (int bj = 0; bj < 2; ++bj)
#pragma unroll
                    for (int n = 0; n < 2; ++n) { const f32x4 x = *(const f32x4*)(resid + off + bj * HALF + n * 16);
                        *(f32x4*)(Z + off + bj * HALF + n * 16) = x * alpha + acc[ai][bj][m][n] * s; }
                if (m & 1) asm volatile("" ::: "memory"); }
    }
};
struct EpiPle {
    static constexpr bool PERM = false, AFTER_DRAIN = false;
    const float* resid; const float* pp; float* Z; int ldc; float alpha;
    __device__ __forceinline__ void operator()(const f32x4 (&acc)[2][2][4][2], const Unit& u, int wr, int wc, int fr, int fq) const {
        const int row0 = u.pm * BM + wr * 64 + fr, col0 = u.pn * BM + wc * 32 + 4 * fq;
#pragma unroll
        for (int ai = 0; ai < 2; ++ai)
#pragma unroll
            for (int m = 0; m < 4; ++m) { const size_t off = (size_t)(row0 + ai * HALF + m * 16) * ldc + col0;
#pragma unroll
                for (int bj = 0; bj < 2; ++bj)
#pragma unroll
                    for (int n = 0; n < 2; ++n) { const f32x4 x = *(const f32x4*)(resid + off + bj * HALF + n * 16); const f32x4 p = *(const f32x4*)(pp + off + bj * HALF + n * 16);
                        const f32x4 a = acc[ai][bj][m][n]; f32x4 sg;
#pragma unroll
                        for (int e = 0; e < 4; ++e) sg[e] = __builtin_amdgcn_rcpf(1.0f + __builtin_amdgcn_exp2f(a[e] * -1.4426950408889634f));
                        *(f32x4*)(Z + off + bj * HALF + n * 16) = x * alpha + sg * p; }
                if (m & 1) asm volatile("" ::: "memory"); }
    }
};
struct EpiSwiGLU {
    static constexpr bool PERM = true, AFTER_DRAIN = false;
    bf16_t* O; int ldc;
    __device__ __forceinline__ void operator()(const f32x4 (&acc)[2][2][4][2], const Unit& u, int wr, int wc, int fr, int fq) const {
        const int row0 = u.pm * BM + wr * 64 + fr, col0 = u.pn * HALF + wc * 32 + 8 * fq;
#pragma unroll
        for (int ai = 0; ai < 2; ++ai)
#pragma unroll
            for (int m = 0; m < 4; ++m) { bf16_t* rowp = O + (size_t)(row0 + ai * HALF + m * 16) * ldc + col0;
                f32x4 h[2];
#pragma unroll
                for (int n = 0; n < 2; ++n) { const f32x4 g = acc[ai][0][m][n], up = acc[ai][1][m][n];
#pragma unroll
                    for (int e = 0; e < 4; ++e) h[n][e] = g[e] * __builtin_amdgcn_rcpf(1.0f + __builtin_amdgcn_exp2f(g[e] * -1.4426950408889634f)) * up[e]; }
                u32x4 w; w.x = cvt_pk_bf16(h[0][0], h[0][1]); w.y = cvt_pk_bf16(h[0][2], h[0][3]); w.z = cvt_pk_bf16(h[1][0], h[1][1]); w.w = cvt_pk_bf16(h[1][2], h[1][3]);
                *(u32x4*)rowp = w; }
    }
};
template <class Epi, class Sched, bool ALIGN_EPI = false, bool SP2 = false>
__device__ __forceinline__ void gemm_phase(PG8_LAS unsigned char* lds, const Gemm g, const Sched& S, const Epi& E) {
    int tid = threadIdx.x; asm volatile("" : "+v"(tid));
    const int wid = __builtin_amdgcn_readfirstlane(tid >> 6), lane = tid & 63, wr = wid >> 2, wc = wid & 3, fr = lane & 15, fq = lane >> 4;
    const int K = g.K, nt = K / BK;
    unsigned voffA[2], voffB[2];
#pragma unroll
    for (int i = 0; i < 2; ++i) { int R, C; stage_rc(tid * 16 + i * 8192, R, C); const int Rb = Epi::PERM ? ((R & ~31) + perm32(R & 31)) : R;
        voffA[i] = (unsigned)(R * K + C) * 2u; voffB[i] = (unsigned)(Rb * K + C) * 2u; }
    const size_t kstep = (size_t)(BK * 2);
    const size_t hstep = (size_t)HALF * K * 2;
    const size_t tstep = 2 * hstep;
    const unsigned ldsw = (unsigned)wid * 1024u;
    const int aoff = lds_byte(wr * 64 + fr, fq * 8), boff = lds_byte(wc * 32 + fr, fq * 8);
#define PG8_SA(b, h) (((b) * 2 + (h)) * HTB)
#define PG8_SB(b, h) ((4 + (b) * 2 + (h)) * HTB)
#define PG8_STAGE(bufoff, gbase, voff) do { _Pragma("unroll") for (int _i = 0; _i < 2; ++_i) \
        __builtin_amdgcn_global_load_lds((const unsigned*)((const char*)(gbase) + (voff)[_i]), (PG8_LAS unsigned*)(lds + (bufoff) + ldsw + _i * 8192), 16, 0, 0); } while (0)
#define PG8_LDA(dst, b, h) do { _Pragma("unroll") for (int m = 0; m < 4; ++m) _Pragma("unroll") for (int k = 0; k < 2; ++k) dst[m][k] = *(const PG8_LAS bf16x8*)(lds + PG8_SA(b, h) + aoff + m * 2048 + k * 1024); } while (0)
#define PG8_LDB(dst, b, h) do { _Pragma("unroll") for (int n = 0; n < 2; ++n) _Pragma("unroll") for (int k = 0; k < 2; ++k) dst[n][k] = *(const PG8_LAS bf16x8*)(lds + PG8_SB(b, h) + boff + n * 2048 + k * 1024); } while (0)
#define PG8_MMA(ai, bj, At, Bt) do { __builtin_amdgcn_s_setprio(1); _Pragma("unroll") for (int m = 0; m < 4; ++m) _Pragma("unroll") for (int n = 0; n < 2; ++n) _Pragma("unroll") for (int k = 0; k < 2; ++k) \
        acc[ai][bj][m][n] = __builtin_amdgcn_mfma_f32_16x16x32_bf16(Bt[n][k], At[m][k], acc[ai][bj][m][n], 0, 0, 0); __builtin_amdgcn_s_setprio(0); } while (0)
#define PG8_WAIT_V(n) asm volatile("s_waitcnt vmcnt(" #n ")" ::: "memory")
#define PG8_WAIT_L(n) asm volatile("s_waitcnt lgkmcnt(" #n ")" ::: "memory")
#define PG8_BAR __builtin_amdgcn_s_barrier()
#define PG8_SCHED __builtin_amdgcn_sched_barrier(0)
    Unit cur, nxt; int ui = 0;
    if (!S.next(0, cur)) return;
    f32x4 acc[2][2][4][2];
#pragma unroll
    for (int a = 0; a < 2; ++a)
#pragma unroll
        for (int b = 0; b < 2; ++b)
#pragma unroll
            for (int m = 0; m < 4; ++m)
#pragma unroll
                for (int n = 0; n < 2; ++n) acc[a][b][m][n] = (f32x4){0.f, 0.f, 0.f, 0.f};
    bf16x8 At[4][2], B0[2][2], B1[2][2];
    const char* cA = (const char*)g.A + (size_t)cur.pm * tstep; const char* cB = (const char*)g.Bt + (size_t)cur.pn * tstep;
    S.a_ready(cur);
    if constexpr (SP2) {
        PG8_STAGE(PG8_SB(0, 0), cB, voffB); PG8_STAGE(PG8_SB(0, 1), cB + hstep, voffB); PG8_STAGE(PG8_SA(0, 0), cA, voffA); PG8_STAGE(PG8_SA(0, 1), cA + hstep, voffA);
        if (wr == 1) PG8_BAR;
        PG8_WAIT_V(2); PG8_BAR;
        PG8_STAGE(PG8_SB(1, 0), cB + kstep, voffB); PG8_STAGE(PG8_SA(1, 0), cA + kstep, voffA); PG8_STAGE(PG8_SB(1, 1), cB + hstep + kstep, voffB);
        PG8_WAIT_V(6); PG8_BAR;
    } else {
        PG8_STAGE(PG8_SB(0, 0), cB, voffB); PG8_STAGE(PG8_SA(0, 0), cA, voffA); PG8_STAGE(PG8_SB(0, 1), cB + hstep, voffB); PG8_STAGE(PG8_SA(0, 1), cA + hstep, voffA);
        if (wr == 1) PG8_BAR;
        PG8_WAIT_V(4); PG8_BAR;
        PG8_STAGE(PG8_SB(1, 0), cB + kstep, voffB); PG8_STAGE(PG8_SA(1, 0), cA + kstep, voffA); PG8_STAGE(PG8_SB(1, 1), cB + hstep + kstep, voffB);
        PG8_WAIT_V(6); PG8_BAR;
    }
    for (;;) {
        const bool has_next = S.next(ui + 1, nxt);
        const char* nA = has_next ? (const char*)g.A + (size_t)nxt.pm * tstep : cA; const char* nB = has_next ? (const char*)g.Bt + (size_t)nxt.pn * tstep : cB;
        for (int t = 0; t < nt; t += 2) {
            const bool last = (t == nt - 2);
            const char* a1 = cA + (size_t)(t + 1) * kstep;
            const char* a2 = last ? nA : cA + (size_t)(t + 2) * kstep; const char* b2 = last ? nB : cB + (size_t)(t + 2) * kstep;
            const char* a3 = a2 + kstep; const char* b3 = b2 + kstep;
            if (last && has_next) S.a_ready(nxt);
            if constexpr (SP2) {
            PG8_LDB(B0, 0, 0); PG8_LDB(B1, 0, 1); PG8_SCHED; PG8_LDA(At, 0, 0); PG8_STAGE(PG8_SA(1, 1), a1 + hstep, voffA);
            PG8_WAIT_V(8); PG8_WAIT_L(0); PG8_BAR; PG8_MMA(0, 0, At, B0); PG8_MMA(0, 1, At, B1); PG8_BAR; PG8_SCHED;
            PG8_LDA(At, 0, 1); PG8_STAGE(PG8_SB(0, 0), b2, voffB); PG8_STAGE(PG8_SB(0, 1), b2 + hstep, voffB); PG8_STAGE(PG8_SA(0, 0), a2, voffA);
            PG8_WAIT_V(8); PG8_WAIT_L(0); PG8_BAR; PG8_MMA(1, 0, At, B0); PG8_MMA(1, 1, At, B1); PG8_BAR; PG8_SCHED;
            PG8_LDB(B0, 1, 0); PG8_LDB(B1, 1, 1); PG8_SCHED; PG8_LDA(At, 1, 0); PG8_STAGE(PG8_SA(0, 1), a2 + hstep, voffA);
            PG8_WAIT_V(8); PG8_WAIT_L(0); PG8_BAR; PG8_MMA(0, 0, At, B0); PG8_MMA(0, 1, At, B1); PG8_BAR; PG8_SCHED;
            PG8_LDA(At, 1, 1); PG8_STAGE(PG8_SB(1, 0), b3, voffB); PG8_STAGE(PG8_SB(1, 1), b3 + hstep, voffB); PG8_STAGE(PG8_SA(1, 0), a3, voffA);
            PG8_WAIT_V(8); PG8_WAIT_L(0); PG8_BAR; PG8_MMA(1, 0, At, B0); PG8_MMA(1, 1, At, B1); PG8_BAR; PG8_SCHED;
            } else {
            PG8_LDB(B0, 0, 0); PG8_SCHED; PG8_LDA(At, 0, 0); PG8_STAGE(PG8_SA(1, 1), a1 + hstep, voffA);
            PG8_WAIT_L(8); PG8_BAR; PG8_WAIT_L(0); PG8_MMA(0, 0, At, B0); PG8_BAR; PG8_SCHED;
            PG8_LDB(B1, 0, 1); PG8_STAGE(PG8_SB(0, 0), b2, voffB);
            PG8_BAR; PG8_WAIT_L(0); PG8_MMA(0, 1, At, B1); PG8_BAR;
            PG8_LDA(At, 0, 1); PG8_STAGE(PG8_SA(0, 0), a2, voffA);
            PG8_BAR; PG8_WAIT_L(0); PG8_MMA(1, 0, At, B0); PG8_BAR; PG8_SCHED;
            PG8_STAGE(PG8_SB(0, 1), b2 + hstep, voffB);
            PG8_WAIT_V(6); PG8_BAR; PG8_MMA(1, 1, At, B1); PG8_BAR;
            PG8_LDB(B0, 1, 0); PG8_SCHED; PG8_LDA(At, 1, 0); PG8_STAGE(PG8_SA(0, 1), a2 + hstep, voffA);
            PG8_WAIT_L(8); PG8_BAR; PG8_WAIT_L(0); PG8_MMA(0, 0, At, B0); PG8_BAR; PG8_SCHED;
            PG8_LDB(B1, 1, 1); PG8_STAGE(PG8_SB(1, 0), b3, voffB);
            PG8_BAR; PG8_WAIT_L(0); PG8_MMA(0, 1, At, B1); PG8_BAR;
            PG8_LDA(At, 1, 1); PG8_STAGE(PG8_SA(1, 0), a3, voffA);
            PG8_BAR; PG8_WAIT_L(0); PG8_MMA(1, 0, At, B0); PG8_BAR; PG8_SCHED;
            PG8_STAGE(PG8_SB(1, 1), b3 + hstep, voffB);
            PG8_WAIT_V(6); PG8_BAR; PG8_MMA(1, 1, At, B1); PG8_BAR;
            }
        }
        if constexpr (ALIGN_EPI) { if (wr == 0) PG8_BAR; }
        if constexpr (!Epi::AFTER_DRAIN) { E(acc, cur, wr, wc, fr, fq); S.done(cur); }
        if (!has_next) break;
#pragma unroll
        for (int a = 0; a < 2; ++a)
#pragma unroll
            for (int b = 0; b < 2; ++b)
#pragma unroll
                for (int m = 0; m < 4; ++m)
#pragma unroll
                    for (int n = 0; n < 2; ++n) acc[a][b][m][n] = (f32x4){0.f, 0.f, 0.f, 0.f};
        cur = nxt; cA = nA; cB = nB; ++ui;
        if constexpr (ALIGN_EPI) { if (wr == 1) PG8_BAR; }
    }
    PG8_WAIT_V(0);
    if constexpr (!ALIGN_EPI) { if (wr == 0) PG8_BAR; }
    PG8_BAR;
    if constexpr (Epi::AFTER_DRAIN) { E.fused(acc, cur, wr, wc, fr, fq, lds, wid, lane); S.done(cur); }
#undef PG8_SA
#undef PG8_SB
#undef PG8_STAGE
#undef PG8_LDA
#undef PG8_LDB
#undef PG8_MMA
#undef PG8_WAIT_V
#undef PG8_WAIT_L
#undef PG8_BAR
#undef PG8_SCHED
}
}
namespace att {
typedef unsigned short bf16;
typedef short bf16x8 __attribute__((ext_vector_type(8)));
typedef short s16x4 __attribute__((ext_vector_type(4)));
typedef float f32x16 __attribute__((ext_vector_type(16)));
typedef float f32x4 __attribute__((ext_vector_type(4)));
typedef unsigned u32x4 __attribute__((ext_vector_type(4)));
typedef unsigned u32x2 __attribute__((ext_vector_type(2)));
constexpr float SCALE = 0.08838834764831845f;
constexpr float THR = 8.f;
constexpr int NW = 8, QBLK = 32, KVBLK = 64, QB = NW * QBLK, D = 128;
constexpr int SHM_V = KVBLK * D * 2, SHM_K = KVBLK * D * 2;
constexpr int LDS_BYTES = 2 * SHM_V + 2 * SHM_K + NW * 64 * 4;
#define KSWZ(row, colB) ((row) * 256 + ((colB) ^ (((row) & 7) << 4)))
#define SBAR() __builtin_amdgcn_sched_barrier(0)
#define ABAR() asm volatile("s_waitcnt lgkmcnt(0)\n\ts_barrier" ::: "memory")
__device__ __forceinline__ int v_st(int k, int c) { const int kk = (k & ~0xC) | ((k & 4) << 1) | ((k & 8) >> 1); return ((kk >> 3) * 4 + (c >> 5)) * 512 + ((kk & 7) * 32 + (c & 31)) * 2; }
__device__ __forceinline__ int v_rd_base(int lane) { return ((lane & 3) << 3) | (((lane >> 2) & 3) << 6) | (((lane >> 4) & 1) << 5) | (((lane >> 5) & 1) << 8); }
constexpr int v_rd_off(int d0, int ks, int half) { return d0 * 512 + ks * 4096 + half * 2048; }
__device__ __forceinline__ int crow(int r, int hi) { return (r & 3) + 8 * (r >> 2) + 4 * hi; }
__device__ __forceinline__ unsigned cvtpk(float lo, float hi) { unsigned r; asm volatile("v_cvt_pk_bf16_f32 %0, %1, %2" : "=v"(r) : "v"(lo), "v"(hi)); return r; }
__device__ __forceinline__ bf16x8 load8(const bf16* p) { return *reinterpret_cast<const bf16x8*>(p); }
__device__ __forceinline__ void mask_causal(f32x16& p0, f32x16& p1, int dq) {
    const float NEG = -__builtin_inff();
#pragma unroll
    for (int r = 0; r < 16; ++r) { const int c = (r & 3) + 8 * (r >> 2); if (dq - c < 0) p0[r] = NEG; if (dq - c - 32 < 0) p1[r] = NEG; }
}
__device__ __forceinline__ void partialSM(f32x16& p0, f32x16& p1, float& m_reg, float& mn, float& alpha) {
    float pmax = p0[0];
#pragma unroll
    for (int r = 1; r < 16; ++r) pmax = fmaxf(pmax, p0[r]);
#pragma unroll
    for (int r = 0; r < 16; ++r) pmax = fmaxf(pmax, p1[r]);
    { auto rr = __builtin_amdgcn_permlane32_swap(__float_as_uint(pmax), __float_as_uint(pmax), false, false);
      pmax = fmaxf(__uint_as_float(rr[0]), __uint_as_float(rr[1])); }
    constexpr float C2 = 1.4426950408889634f * SCALE;
    if (__builtin_expect(__all((pmax - m_reg) * SCALE <= THR), 1)) { mn = m_reg; alpha = 1.f; }
    else { mn = fmaxf(m_reg, pmax); alpha = __builtin_amdgcn_exp2f((m_reg - mn) * C2); m_reg = mn; }
    const float mnL = -mn * C2;
#pragma unroll
    for (int r = 0; r < 16; ++r) p0[r] = fmaf(p0[r], C2, mnL);
#pragma unroll
    for (int r = 0; r < 16; ++r) p1[r] = fmaf(p1[r], C2, mnL);
#pragma unroll
    for (int r = 0; r < 16; ++r) p0[r] = __builtin_amdgcn_exp2f(p0[r]);
}
__device__ __forceinline__ void finishSM(f32x16& p0, f32x16& p1, float alpha, float& l_reg, bf16x8& pa0, bf16x8& pa1, bf16x8& pa2, bf16x8& pa3) {
#pragma unroll
    for (int r = 0; r < 16; ++r) p1[r] = __builtin_amdgcn_exp2f(p1[r]);
    float ps = 0;
#pragma unroll
    for (int r = 0; r < 16; ++r) ps += p0[r];
#pragma unroll
    for (int r = 0; r < 16; ++r) ps += p1[r];
    { auto rr = __builtin_amdgcn_permlane32_swap(__float_as_uint(ps), __float_as_uint(ps), false, false);
      ps = __uint_as_float(rr[0]) + __uint_as_float(rr[1]); }
    l_reg = l_reg * alpha + ps;
#define PK4(P, B_, OUT) do { unsigned a0 = cvtpk(P[B_+0], P[B_+1]), a1 = cvtpk(P[B_+2], P[B_+3]);                          \
        unsigned b0 = cvtpk(P[B_+4], P[B_+5]), b1 = cvtpk(P[B_+6], P[B_+7]);                                             \
        auto r0 = __builtin_amdgcn_permlane32_swap(a0, b0, false, false); auto r1 = __builtin_amdgcn_permlane32_swap(a1, b1, false, false); \
        u32x4 w = {r0[0], r1[0], r0[1], r1[1]}; OUT = *reinterpret_cast<bf16x8*>(&w); } while (0)
    PK4(p0, 0, pa0); PK4(p0, 8, pa1); PK4(p1, 0, pa2); PK4(p1, 8, pa3);
#undef PK4
}
template <int KB, int MODE>
__device__ __forceinline__ void qkt(f32x16& p0, f32x16& p1, const char* K_lds, int r32, int hi, const bf16x8* qr, float base, float slopeS, unsigned w0, unsigned w1) {
    const float NEG = -__builtin_inff();
#pragma unroll
    for (int r = 0; r < 16; ++r) { const int c = (r & 3) + 8 * (r >> 2);
        float b0 = fmaf(slopeS, (float)c, base), b1 = fmaf(slopeS, (float)(c + 32), base);
        if (MODE == 2) { b0 = ((w0 >> c) & 1u) ? b0 : NEG; b1 = ((w1 >> c) & 1u) ? b1 : NEG; }
        p0[r] = b0; p1[r] = b1; }
    const char* kb[4];
#pragma unroll
    for (int dd = 0; dd < 4; ++dd) kb[dd] = K_lds + KB * SHM_K + KSWZ(r32, (dd * 16 + hi * 8) * 2);
#pragma unroll
    for (int d0 = 0; d0 < 8; ++d0) { const char* a = kb[d0 & 3] + (d0 >> 2) * 128;
        bf16x8 b0 = *reinterpret_cast<const bf16x8*>(a);
        bf16x8 b1 = *reinterpret_cast<const bf16x8*>(a + 32 * 256);
        p0 = __builtin_amdgcn_mfma_f32_32x32x16_bf16(b0, qr[d0], p0, 0, 0, 0);
        p1 = __builtin_amdgcn_mfma_f32_32x32x16_bf16(b1, qr[d0], p1, 0, 0, 0); }
}
template <int VB>
__device__ __forceinline__ void pv_tile(f32x16* o, int vb0, bf16x8 pa0, bf16x8 pa1, bf16x8 pa2, bf16x8 pa3) {
#define TRRD(dst, off) asm volatile("ds_read_b64_tr_b16 %0, %1 offset:%2" : "=&v"(dst) : "v"(vb0), "i"(off) : "memory")
#define PV_D0(d0) do { s16x4 l0, l1, l2, l3, h0, h1, h2, h3; constexpr int b_ = VB * SHM_V + v_rd_off(d0, 0, 0); \
        TRRD(l0, b_); TRRD(h0, b_ + 2048); TRRD(l1, b_ + 4096); TRRD(h1, b_ + 6144); TRRD(l2, b_ + 8192); TRRD(h2, b_ + 10240); TRRD(l3, b_ + 12288); TRRD(h3, b_ + 14336); \
        asm volatile("s_waitcnt lgkmcnt(0)" ::: "memory"); SBAR();   \
        o[d0] = __builtin_amdgcn_mfma_f32_32x32x16_bf16(pa0, (bf16x8){l0[0], l0[1], l0[2], l0[3], h0[0], h0[1], h0[2], h0[3]}, o[d0], 0, 0, 0);   \
        o[d0] = __builtin_amdgcn_mfma_f32_32x32x16_bf16(pa1, (bf16x8){l1[0], l1[1], l1[2], l1[3], h1[0], h1[1], h1[2], h1[3]}, o[d0], 0, 0, 0);   \
        o[d0] = __builtin_amdgcn_mfma_f32_32x32x16_bf16(pa2, (bf16x8){l2[0], l2[1], l2[2], l2[3], h2[0], h2[1], h2[2], h2[3]}, o[d0], 0, 0, 0);   \
        o[d0] = __builtin_amdgcn_mfma_f32_32x32x16_bf16(pa3, (bf16x8){l3[0], l3[1], l3[2], l3[3], h3[0], h3[1], h3[2], h3[3]}, o[d0], 0, 0, 0); } while (0)
    PV_D0(0); PV_D0(1); PV_D0(2); PV_D0(3);
#undef PV_D0
#undef TRRD
}
struct Blk { const bf16* Q; const bf16* K; const bf16* V; bf16* O; int P0; float slopeS; const unsigned char* rm; const unsigned* bits; };
struct Seam { bf16x8 qr[8]; bf16x8 st_v0, st_v1, st_k0, st_k1; };
#define ROW(p, k0, rr) ((p) + (size_t)((k0) + (rr)) * pitch + sc)
#define VMW() asm volatile("s_waitcnt vmcnt(0)" ::: "memory")
#define VMWN(n) asm volatile("s_waitcnt vmcnt(%0)" :: "i"(n) : "memory")
#define SLOAD_H(Kp, Vp, k0) do { S.st_v0 = load8(ROW(Vp, k0, sr)); S.st_v1 = load8(ROW(Vp, k0, 32 + sr));              \
                         S.st_k0 = load8(ROW(Kp, k0, sr)); S.st_k1 = load8(ROW(Kp, k0, 32 + sr)); } while (0)
#define SWRITE_HK(bf) do { *(bf16x8*)(K_lds + (bf) * SHM_K + kws) = S.st_k0; *(bf16x8*)(K_lds + (bf) * SHM_K + kws + 32 * 256) = S.st_k1; } while (0)
#define SWRITE_HV(bf) do { *(bf16x8*)(V_lds + (bf) * SHM_V + vst0) = S.st_v0; *(bf16x8*)(V_lds + (bf) * SHM_V + vst1) = S.st_v1; } while (0)
#define SWRITE_H(bf) do { SWRITE_HV(bf); SWRITE_HK(bf); } while (0)
__device__ __forceinline__ void attn_prime(const Blk& cur, int pitch, char* lds, Seam& S) {
    int tid = threadIdx.x; asm volatile("" : "+v"(tid));
    const int wid = __builtin_amdgcn_readfirstlane(tid >> 6), lane = tid & 63, r32 = lane & 31, hi = lane >> 5;
    const int sr = tid >> 4, sc = (tid & 15) * 8, kws = KSWZ(sr, sc * 2); char* K_lds = lds + 2 * SHM_V;
#pragma unroll
    for (int d0 = 0; d0 < 8; ++d0) S.qr[d0] = load8(cur.Q + (size_t)(wid * QBLK + r32) * pitch + d0 * 16 + hi * 8);
    SLOAD_H(cur.K, cur.V, 0); VMW(); SWRITE_HK(0);
    ABAR();
}
template <int MODE>
__device__ __forceinline__ void attn_block(const Blk& cur, const Blk& nxt, int pitch, int opitch, char* lds, Seam& S) {
    int tid = threadIdx.x; asm volatile("" : "+v"(tid));
    const int wid = __builtin_amdgcn_readfirstlane(tid >> 6), lane = tid & 63, r32 = lane & 31, hi = lane >> 5;
    const int NT = (cur.P0 + QB) / KVBLK;
    const int qlo = cur.P0 + wid * QBLK, qm = qlo + r32 - 4 * hi;
    char* V_lds = lds; char* K_lds = lds + 2 * SHM_V;
    float* ws = (float*)(lds + 2 * SHM_V + 2 * SHM_K) + wid * 64; float* li_l = ws, * al_l = ws + 32;
    float m_reg = -1e30f, l_reg = 0; f32x16 o[4] = {};
    const int sr = tid >> 4, sc = (tid & 15) * 8, vst0 = v_st(sr, sc), vst1 = v_st(32 + sr, sc), kws = KSWZ(sr, sc * 2);
    const int vb0 = (int)(uintptr_t)V_lds + v_rd_base(lane);
    const bf16* Kh = cur.K; const bf16* Vh = cur.V;
    const float slopeS = cur.slopeS; const float NEGINF = -__builtin_inff();
    unsigned rmv = 0; if (MODE == 1) rmv = cur.rm[(size_t)(wid * QBLK + r32) * 16];
    const unsigned* bp = cur.bits + (size_t)(wid * QBLK + r32) * 64; u32x2 bw = {0u, 0u};
    if (MODE == 2) bw = *(const u32x2*)bp;
#define RESC(a) do { if (__any((a) < 1.f)) { if (hi == 0) al_l[r32] = (a); asm volatile("s_waitcnt lgkmcnt(0)" ::: "memory");              \
                     _Pragma("unroll") for (int d_ = 0; d_ < 4; ++d_) _Pragma("unroll") for (int r = 0; r < 16; ++r) o[d_][r] *= al_l[crow(r, hi)]; } } while (0)
#define KBASE(t) ((t) * KVBLK)
#define MASKT(P0_, P1_, t) do { if (MODE != 2) { const int kb_ = KBASE(t); if (kb_ + KVBLK - 1 > qlo) mask_causal(P0_, P1_, qm - kb_); } } while (0)
#define QKT(KB, PX0, PX1, t) do { const int kb_ = KBASE(t); float base_ = -slopeS * (float)(qm - kb_);                                     \
        if (MODE == 1) { if (!((rmv >> (kb_ >> 8)) & 1u)) base_ = NEGINF; }                                                                 \
        qkt<KB, MODE>(PX0, PX1, K_lds, r32, hi, S.qr, base_, slopeS, bw[0] >> (4 * hi), bw[1] >> (4 * hi));                                 \
        if (MODE == 2) { if ((t) + 1 < NT) bw = *(const u32x2*)(bp + 2 * ((t) + 1)); } } while (0)
#define SEAM_K0() do { VMWN(8); SWRITE_HK(0); SBAR(); } while (0)
    f32x16 pA0, pA1, pB0, pB1; float mnA, mnB, alA, alB; bf16x8 pa0, pa1, pa2, pa3;
    SWRITE_HV(0); SBAR();
    SLOAD_H(Kh, Vh, KBASE(1));
    SBAR(); QKT(0, pA0, pA1, 0);
    MASKT(pA0, pA1, 0); partialSM(pA0, pA1, m_reg, mnA, alA);
    VMW(); SWRITE_H(1);
    ABAR();
#define HALF_STEP(PX0, PX1, mnX, alX, PY0, PY1, alY, t, KB, VB, SB) do {                                                      \
        SBAR(); QKT(KB, PX0, PX1, t);                                                                                         \
        finishSM(PY0, PY1, alY, l_reg, pa0, pa1, pa2, pa3); SBAR();                                                           \
        if ((t) + 1 < NT) { SLOAD_H(Kh, Vh, KBASE((t) + 1)); SBAR(); }                                                        \
        pv_tile<VB>(o, vb0, pa0, pa1, pa2, pa3); MASKT(PX0, PX1, (t)); partialSM(PX0, PX1, m_reg, mnX, alX);                  \
        ABAR();                                                                                                               \
        if ((t) + 1 < NT) { VMW(); SWRITE_H(SB); }                                                                            \
        RESC(alX); ABAR(); } while (0)
    for (int t = 1; t + 1 < NT; t += 2) {
        HALF_STEP(pB0, pB1, mnB, alB, pA0, pA1, alA, t, 1, 0, 0);
        HALF_STEP(pA0, pA1, mnA, alA, pB0, pB1, alB, t + 1, 0, 1, 1);
    }
    SBAR(); QKT(1, pB0, pB1, NT - 1); SBAR();
    SLOAD_H(nxt.K, nxt.V, 0); SBAR();
#pragma unroll
    for (int d0 = 0; d0 < 8; ++d0) S.qr[d0] = load8(nxt.Q + (size_t)(wid * QBLK + r32) * pitch + d0 * 16 + hi * 8);
    SBAR();
    finishSM(pA0, pA1, alA, l_reg, pa0, pa1, pa2, pa3); SBAR();
    pv_tile<0>(o, vb0, pa0, pa1, pa2, pa3);
    MASKT(pB0, pB1, NT - 1); partialSM(pB0, pB1, m_reg, mnB, alB); ABAR(); RESC(alB);
    finishSM(pB0, pB1, alB, l_reg, pa0, pa1, pa2, pa3); SBAR(); pv_tile<1>(o, vb0, pa0, pa1, pa2, pa3);
    SBAR(); SEAM_K0();
    if (hi == 0) li_l[r32] = l_reg; asm volatile("s_waitcnt lgkmcnt(0)" ::: "memory");
    float rli[16];
#pragma unroll
    for (int r = 0; r < 16; ++r) rli[r] = __builtin_amdgcn_rcpf(li_l[crow(r, hi)]);
    bf16* Ow = cur.O + (size_t)(wid * QBLK) * opitch;
#pragma unroll
    for (int r = 0; r < 16; ++r) { const int orow = crow(r, hi);
#pragma unroll
        for (int d0 = 0; d0 < 4; ++d0) { const float v = o[d0][r] * rli[r];
            const float vn = __int_as_float(__builtin_amdgcn_update_dpp(0, __float_as_int(v), 0xB1, 0xf, 0xf, true));
            if ((r32 & 1) == 0) *(unsigned*)(Ow + (size_t)orow * opitch + d0 * 32 + r32) = cvtpk(v, vn); } }
    ABAR();
#undef RESC
#undef KBASE
#undef MASKT
#undef QKT
#undef SEAM_K0
#undef HALF_STEP
}
#undef ROW
#undef SLOAD_H
#undef SWRITE_HK
#undef SWRITE_HV
#undef SWRITE_H
template <int MODE>
__device__ __forceinline__ Blk make_blk(int L, int pass, int total, const bf16* QKV, int pitch, bf16* Obuf, int opitch, const unsigned char* rowmask, const unsigned* selbits) {
    const int v = (L & 7) * (total >> 3) + (L >> 3);
    const int bh = v >> 2, x = v & 3, qb = pass ? 7 - x : x;
    const int nh = total >> 4, b = bh / nh, hh = bh - b * nh;
    const size_t row0 = (size_t)b * 2048 + (size_t)qb * QB;
    int qcol, kcol, vcol, ocol; float slope;
    if (MODE == 0) { const int h = hh >> 2, m = (hh >> 1) & 1, vf = hh & 1; qcol = h * 256 + m * 128; kcol = 2048 + qcol; vcol = 4096 + h * 256 + vf * 128; ocol = (h * 2 + m) * 256 + vf * 128; slope = __builtin_amdgcn_exp2f(-(float)(h + 1)); }
    else if (MODE == 1) { qcol = hh * 128; kcol = 2048 + qcol; vcol = 4096 + qcol; ocol = qcol; slope = __builtin_amdgcn_exp2f(-0.5f * (float)(hh + 1)); }
    else { const int g = hh >> 2; qcol = hh * 128; kcol = 2048 + g * 128; vcol = 2560 + g * 128; ocol = qcol; slope = __builtin_amdgcn_exp2f(-0.5f * (float)(hh + 1)); }
    Blk r;
    r.Q = QKV + row0 * pitch + qcol; r.K = QKV + (size_t)b * 2048 * pitch + kcol; r.V = QKV + (size_t)b * 2048 * pitch + vcol;
    r.O = Obuf + row0 * opitch + ocol; r.P0 = qb * QB; r.slopeS = slope * (1.0f / SCALE);
    r.rm = rowmask + row0 * 16 + hh; r.bits = selbits + row0 * 64;
    return r;
}
template <int MODE>
__device__ __forceinline__ void attn_phase(char* lds, const bf16* QKV, int pitch, bf16* Obuf, int opitch, const unsigned char* rowmask, const unsigned* selbits, int nheads, int blk, int G) {
    const int total = 16 * nheads;
    int L = blk; if (L >= total) return;
    int pass = 0;
    Blk cur = make_blk<MODE>(L, 0, total, QKV, pitch, Obuf, opitch, rowmask, selbits);
    Seam S;
    attn_prime(cur, pitch, lds, S);
    for (;;) {
        const bool more_pass = pass == 0, more_item = L + G < total, last = !more_pass && !more_item;
        int passn = pass + 1, Ln = L;
        if (!more_pass) { passn = 0; Ln = more_item ? L + G : L; }
        const Blk nxt = last ? cur : make_blk<MODE>(Ln, passn, total, QKV, pitch, Obuf, opitch, rowmask, selbits);
        attn_block<MODE>(cur, nxt, pitch, opitch, lds, S);
        if (last) break;
        cur = nxt; pass = passn; L = Ln;
    }
}
#undef SBAR
#undef ABAR
#undef VMW
#undef VMWN
#undef KSWZ
}
#ifndef PG8_SP2
#define PG8_SP2 true
#endif
#ifndef PG8_ALIGN
#define PG8_ALIGN true
#endif
#ifndef MK_PER_PHASE
#define MK_PER_PHASE 1
#endif
constexpr int NWAVES = 8;
constexpr int T_TOK = 8192, SEQ = 2048, DM = 2048, FF = 5632, PLE = 256, DEPTH = 4;
constexpr int NA_IN = 6144, NC_IN_PAD = 4352, NC_IN = 4176;
constexpr float LN_EPS = 1e-5f, RMS_EPS = 1e-6f;
constexpr float ALPHA = 1.681792830507429f;
constexpr size_t MiB = 1u << 20;
constexpr size_t WS_CTL = 0, CTL_ZERO_BYTES = 1 * MiB;
constexpr size_t WS_W = 1 * MiB;
constexpr size_t LW_F1IN = 0, LW_F1OUT = 44 * MiB, LW_F2IN = 66 * MiB, LW_F2OUT = 110 * MiB, LW_PG = 132 * MiB, LW_PP = 140 * MiB, LW_BYTES = 141 * MiB;
constexpr size_t WS_MIX = WS_W + 4 * LW_BYTES;
constexpr size_t MW_A_IN = 0, MW_A_OUT = 24 * MiB, MW_A_STRIDE = 32 * MiB, MW_B_IN = 64 * MiB, MW_B_OUT = 88 * MiB, MW_C_IN = 96 * MiB, MW_C_OUT = 113 * MiB, MW_BYTES = 121 * MiB;
constexpr size_t WS_X = WS_MIX + MW_BYTES;
constexpr size_t WS_Z = WS_X + 64 * MiB;
constexpr size_t WS_XB = WS_Z + 64 * MiB;
constexpr size_t WS_H = WS_XB + 32 * MiB;
constexpr size_t WS_QKV = WS_H + 88 * MiB;
constexpr size_t WS_AO = WS_QKV + 96 * MiB;
constexpr size_t WS_OP = WS_AO + 32 * MiB;
constexpr size_t WS_PP = WS_OP + 64 * MiB;
constexpr size_t WS_PB = WS_PP + 64 * MiB;
constexpr size_t WS_SEL = WS_PB + 16 * MiB;
constexpr size_t WS_RM = WS_SEL + 2 * MiB;
constexpr size_t WS_END = WS_RM + 1 * MiB;
constexpr int CW_TMO = 0, CW_CODE = 1, CW_BAR = 4096;
constexpr int RING_OFF = 0, RING_BYTES = 131072;
constexpr int LDSCTL_OFF = RING_BYTES, MISC_OFF = LDSCTL_OFF + 320;
constexpr int LDS_BYTES = 147456;
static_assert(MISC_OFF + 128 <= LDS_BYTES && att::LDS_BYTES <= RING_BYTES, "LDS map");
#define GAS __attribute__((address_space(1)))
#define LAS __attribute__((address_space(3)))
typedef unsigned short bf16;
typedef unsigned v4u __attribute__((ext_vector_type(4)));
typedef float f32x4 __attribute__((ext_vector_type(4)));
typedef short bf16x8 __attribute__((ext_vector_type(8)));
typedef GAS unsigned gu32;
typedef GAS unsigned long long gu64;
#define RLX_AGENT __ATOMIC_RELAXED, __HIP_MEMORY_SCOPE_AGENT
#define LDS_WAIT() asm volatile("s_waitcnt lgkmcnt(0)" ::: "memory")
#define VM_WAIT() asm volatile("s_waitcnt vmcnt(0)" ::: "memory")
__device__ __forceinline__ unsigned long long rt() { return __builtin_amdgcn_s_memrealtime(); }
__device__ __forceinline__ unsigned f2bf(float f) { unsigned u = __builtin_bit_cast(unsigned, f); return (u + 0x7fffu + ((u >> 16) & 1u)) >> 16; }
__device__ __forceinline__ unsigned pk2(float lo, float hi) { return f2bf(lo) | (f2bf(hi) << 16); }
#define XB_TMO      128
#define XB_XCNT(j)  (256  + 64 * (j))
#define XB_XSUB(j)  (1280 + 64 * (j))
#define XB_XGEN(j)  (2304 + 64 * (j))
#define XB_TOP      3328
#define XB_TOPGEN   3392
#define XCD_BAR_WORDS 3456
#define XB_SPIN_CAP (1u << 18)

__device__ __forceinline__ unsigned xb_ld(unsigned* p)              { return __hip_atomic_load((GAS unsigned*)p, __ATOMIC_RELAXED, __HIP_MEMORY_SCOPE_AGENT); }
__device__ __forceinline__ unsigned xb_add(unsigned* p, unsigned v) { return __hip_atomic_fetch_add((GAS unsigned*)p, v, __ATOMIC_RELAXED, __HIP_MEMORY_SCOPE_AGENT); }
__device__ __forceinline__ unsigned xb_xcc_id() { return (unsigned)__builtin_amdgcn_s_getreg((3 << 11) | 20) & 0xFu; }
#define XB_SPIN(cond, bar) do { unsigned _sp = 0; while (cond) { __builtin_amdgcn_s_sleep(1); \
    if ((++_sp & 255u) == 0u) { if (xb_ld(&(bar)[XB_TMO])) break; if (_sp > XB_SPIN_CAP) { (void)xb_add(&(bar)[XB_TMO], 1u); break; } } } } while (0)

struct XcdBarrier {
    unsigned* bar; unsigned x;
    volatile LAS unsigned* st;
};

__device__ __forceinline__ XcdBarrier xcd_barrier_post(unsigned* bar, volatile LAS unsigned* st) {
    XcdBarrier b; b.bar = bar; b.x = xb_xcc_id(); b.st = st;
    if (threadIdx.x == 0) (void)xb_add(&bar[XB_XCNT(b.x)], 1u);
    return b;
}
__device__ __forceinline__ void xcd_barrier_complete(unsigned* bar, unsigned x, unsigned& nloc, unsigned& nx) {
    const unsigned G = gridDim.x * gridDim.y * gridDim.z;
    unsigned sum, cnt, mine, sp = 0u;
    for (;;) {
        sum = 0u; cnt = 0u; mine = 0u;
#pragma unroll
        for (unsigned j = 0; j < 16; ++j) { const unsigned c = xb_ld(&bar[XB_XCNT(j)]); sum += c; cnt += (c > 0u) ? 1u : 0u; mine = (j == x) ? c : mine; }
        if (sum == G) break;
        __builtin_amdgcn_s_sleep(1);
        if ((++sp & 255u) == 0u) { if (xb_ld(&bar[XB_TMO])) break; if (sp > XB_SPIN_CAP) { (void)xb_add(&bar[XB_TMO], 1u); break; } }
    }
    nloc = mine > 0u ? mine : 1u; nx = cnt > 0u ? cnt : 1u;
}

__device__ __forceinline__ void xcd_barrier(const XcdBarrier& b) {
    asm volatile("s_waitcnt vmcnt(0)" ::: "memory");
    __syncthreads();
    if (threadIdx.x == 0) {
        unsigned* bar = b.bar;
        __builtin_amdgcn_s_waitcnt(0);
        unsigned nloc = b.st[0], nx = b.st[1];
        if (nloc == 0u) { xcd_barrier_complete(bar, b.x, nloc, nx); b.st[0] = nloc; b.st[1] = nx; }
        const unsigned old = xb_add(&bar[XB_XSUB(b.x)], 1u);
        const unsigned gen = old / nloc;
        if (old + 1u == (gen + 1u) * nloc) {
            __builtin_amdgcn_fence(__ATOMIC_RELEASE, "agent");
            asm volatile("s_waitcnt vmcnt(0)" ::: "memory");
            const unsigned og = xb_add(&bar[XB_TOP], 1u);
            const unsigned tg = og / nx;
            if (og + 1u == (tg + 1u) * nx) xb_add(&bar[XB_TOPGEN], 1u);
            else XB_SPIN(xb_ld(&bar[XB_TOPGEN]) == tg, bar);
            __builtin_amdgcn_fence(__ATOMIC_ACQUIRE, "agent");
            xb_add(&bar[XB_XGEN(b.x)], 1u);
            asm volatile("s_waitcnt vmcnt(0)" ::: "memory");
        } else {
            XB_SPIN(xb_ld(&bar[XB_XGEN(b.x)]) == gen, bar);
            __builtin_amdgcn_fence(__ATOMIC_ACQUIRE, "agent");
            asm volatile("s_waitcnt vmcnt(0)" ::: "memory");
        }
    }
    __syncthreads();
}
typedef unsigned u32x2 __attribute__((ext_vector_type(2)));
typedef float f32x16 __attribute__((ext_vector_type(16)));
__device__ __forceinline__ unsigned cvtpk2(float lo, float hi) { unsigned r; asm volatile("v_cvt_pk_bf16_f32 %0, %1, %2" : "=v"(r) : "v"(lo), "v"(hi)); return r; }
__device__ __forceinline__ float bf2f(unsigned short h) { return __uint_as_float((unsigned)h << 16); }
template <int M> __device__ __forceinline__ int swz_xor_i(int v) {
    if (M == 1) return __builtin_amdgcn_update_dpp(v, v, 0xB1, 0xf, 0xf, true);
    else if (M == 2) return __builtin_amdgcn_update_dpp(v, v, 0x4E, 0xf, 0xf, true);
    else return __builtin_amdgcn_ds_swizzle(v, (M << 10) | 0x1f);
}
template <int M> __device__ __forceinline__ float swz_xor(float v) { return __int_as_float(swz_xor_i<M>(__float_as_int(v))); }
__device__ __forceinline__ float wave_sum(float v) {
    v += swz_xor<1>(v); v += swz_xor<2>(v); v += swz_xor<4>(v); v += swz_xor<8>(v); v += swz_xor<16>(v);
    auto rr = __builtin_amdgcn_permlane32_swap(__float_as_uint(v), __float_as_uint(v), false, false);
    return __uint_as_float(rr[0]) + __uint_as_float(rr[1]);
}
struct WDesc { const float* src; bf16* dst; int K, N, Npad, mode; };
__device__ __forceinline__ void transpose_item(const WDesc& d, LAS float* scr, int item, int lane) {
    const int nblk = d.Npad / 32, kb = item / nblk, nb = item - kb * nblk, k0 = 64 * kb, n0 = 32 * nb;
    const int nn = n0 + (lane & 31); const bool ok = nn < d.N;
#pragma unroll 8
    for (int i = 0; i < 32; ++i) { const int kk = 2 * i + (lane >> 5); scr[kk * 33 + (lane & 31)] = ok ? d.src[(size_t)(k0 + kk) * d.N + nn] : 0.f; }
    LDS_WAIT(); asm volatile("" ::: "memory");
    int drow0 = n0;
    if (d.mode == 1) { const int bj = n0 >= FF ? 1 : 0, cc = n0 - bj * FF; drow0 = 256 * (cc >> 7) + 128 * bj + (cc & 127); }
    const int c = lane & 7;
#pragma unroll
    for (int j = 0; j < 4; ++j) { const int n = (lane >> 3) + 8 * j; const LAS float* s = scr + (8 * c) * 33 + n;
        v4u o; o.x = cvtpk2(s[0 * 33], s[1 * 33]); o.y = cvtpk2(s[2 * 33], s[3 * 33]); o.z = cvtpk2(s[4 * 33], s[5 * 33]); o.w = cvtpk2(s[6 * 33], s[7 * 33]);
        *(GAS v4u*)(d.dst + (size_t)(drow0 + n) * d.K + k0 + 8 * c) = o; }
    LDS_WAIT(); asm volatile("" ::: "memory");
}
struct Args { const float* in[21]; float* out; unsigned char* ws; int ph_lo, ph_hi; };
__device__ __forceinline__ const void* karg_ptr(unsigned off);
__device__ __forceinline__ WDesc wdesc(unsigned char* ws, int mi) {
    WDesc d; d.mode = 0;
    if (mi < 24) { const int l = mi / 6, k = mi - 6 * l; unsigned char* lb = ws + WS_W + (size_t)l * LW_BYTES;
        if (k == 0)      { d.src = ((const float*)karg_ptr(8u * 2)) + (size_t)l * DM * 2 * FF; d.dst = (bf16*)(lb + LW_F1IN);  d.K = DM;  d.N = 2 * FF; d.mode = 1; }
        else if (k == 1) { d.src = ((const float*)karg_ptr(8u * 3)) + (size_t)l * FF * DM;     d.dst = (bf16*)(lb + LW_F1OUT); d.K = FF;  d.N = DM; }
        else if (k == 2) { d.src = ((const float*)karg_ptr(8u * 4)) + (size_t)l * DM * 2 * FF; d.dst = (bf16*)(lb + LW_F2IN);  d.K = DM;  d.N = 2 * FF; d.mode = 1; }
        else if (k == 3) { d.src = ((const float*)karg_ptr(8u * 5)) + (size_t)l * FF * DM;     d.dst = (bf16*)(lb + LW_F2OUT); d.K = FF;  d.N = DM; }
        else if (k == 4) { d.src = ((const float*)karg_ptr(8u * 8)) + (size_t)l * DM * DM;     d.dst = (bf16*)(lb + LW_PG);    d.K = DM;  d.N = DM; }
        else             { d.src = ((const float*)karg_ptr(8u * 9)) + (size_t)l * PLE * DM;    d.dst = (bf16*)(lb + LW_PP);    d.K = PLE; d.N = DM; }
        d.Npad = d.N; return d; }
    unsigned char* mb = ws + WS_MIX; const int k = mi - 24;
    if (k == 0)      { d.src = ((const float*)karg_ptr(8u * 10));                         d.dst = (bf16*)(mb + MW_A_IN);                d.K = DM; d.N = NA_IN; }
    else if (k == 1) { d.src = ((const float*)karg_ptr(8u * 11));                         d.dst = (bf16*)(mb + MW_A_OUT);               d.K = DM; d.N = DM; }
    else if (k == 2) { d.src = ((const float*)karg_ptr(8u * 10)) + (size_t)DM * NA_IN;    d.dst = (bf16*)(mb + MW_A_STRIDE + MW_A_IN);  d.K = DM; d.N = NA_IN; }
    else if (k == 3) { d.src = ((const float*)karg_ptr(8u * 11)) + (size_t)DM * DM;       d.dst = (bf16*)(mb + MW_A_STRIDE + MW_A_OUT); d.K = DM; d.N = DM; }
    else if (k == 4) { d.src = ((const float*)karg_ptr(8u * 17));                         d.dst = (bf16*)(mb + MW_B_IN);                d.K = DM; d.N = NA_IN; }
    else if (k == 5) { d.src = ((const float*)karg_ptr(8u * 18));                         d.dst = (bf16*)(mb + MW_B_OUT);               d.K = DM; d.N = DM; }
    else if (k == 6) { d.src = ((const float*)karg_ptr(8u * 19));                         d.dst = (bf16*)(mb + MW_C_IN);                d.K = DM; d.N = NC_IN; d.Npad = NC_IN_PAD; return d; }
    else             { d.src = ((const float*)karg_ptr(8u * 20));                         d.dst = (bf16*)(mb + MW_C_OUT);               d.K = DM; d.N = DM; }
    d.Npad = d.N; return d;
}
constexpr int N_WMATS = 32;
__device__ __forceinline__ void cvt_rows(const float* src, bf16* dst, size_t n, int gt, int ngt) {
    for (size_t i = (size_t)gt * 8; i < n; i += (size_t)ngt * 8) { const f32x4 a = *(const GAS f32x4*)(src + i), b = *(const GAS f32x4*)(src + i + 4);
        v4u o; o.x = cvtpk2(a.x, a.y); o.y = cvtpk2(a.z, a.w); o.z = cvtpk2(b.x, b.y); o.w = cvtpk2(b.z, b.w); *(GAS v4u*)(dst + i) = o; }
}
__device__ __forceinline__ void ln_phase(const float* Z, const float* g, const float* b, float* X, bf16* XB, int gw, int ngw, int lane) {
    f32x4 gv[8], bv[8];
#pragma unroll
    for (int j = 0; j < 8; ++j) { gv[j] = *((const GAS f32x4*)g + lane + 64 * j); bv[j] = *((const GAS f32x4*)b + lane + 64 * j); }
    for (int row = gw; row < T_TOK; row += ngw) {
        const GAS f32x4* zr = (const GAS f32x4*)(Z + (size_t)row * DM) + lane;
        f32x4 v[8]; float s = 0.f;
#pragma unroll
        for (int j = 0; j < 8; ++j) { v[j] = zr[64 * j]; s += (v[j].x + v[j].y) + (v[j].z + v[j].w); }
        const float mean = wave_sum(s) * (1.f / DM); float s2 = 0.f;
#pragma unroll
        for (int j = 0; j < 8; ++j) { v[j] = v[j] - mean; s2 += (v[j].x * v[j].x + v[j].y * v[j].y) + (v[j].z * v[j].z + v[j].w * v[j].w); }
        const float rstd = 1.f / sqrtf(wave_sum(s2) * (1.f / DM) + LN_EPS);
        GAS f32x4* xo = (GAS f32x4*)(X + (size_t)row * DM) + lane;
#pragma unroll
        for (int j = 0; j < 8; ++j) { v[j] = v[j] * rstd * gv[j] + bv[j]; xo[64 * j] = v[j]; }
        if (XB) { GAS u32x2* o8 = (GAS u32x2*)(XB + (size_t)row * DM) + lane;
#pragma unroll
            for (int j = 0; j < 8; ++j) { u32x2 w; w.x = cvtpk2(v[j].x, v[j].y); w.y = cvtpk2(v[j].z, v[j].w); o8[64 * j] = w; } }
    }
}
__device__ __forceinline__ void diff_combine_phase(const bf16* OP, bf16* AO, const float* lq1, const float* lk1, const float* lq2, const float* lk2, const float* sg, float lambda_init, int gw, int ngw, int lane) {
    const float s1 = wave_sum(lq1[lane] * lk1[lane] + lq1[lane + 64] * lk1[lane + 64]);
    const float s2 = wave_sum(lq2[lane] * lk2[lane] + lq2[lane + 64] * lk2[lane + 64]);
    const float lam = expf(s1) - expf(s2) + lambda_init;
    const f32x4 gg = *((const GAS f32x4*)sg + lane); const float post = 1.0f - lambda_init;
    for (int row = gw; row < T_TOK; row += ngw) {
        const GAS u32x2* src = (const GAS u32x2*)(OP + (size_t)row * 4096) + lane;
        u32x2 a[8], b[8];
#pragma unroll
        for (int h = 0; h < 8; ++h) { a[h] = src[h * 128]; b[h] = src[h * 128 + 64]; }
#pragma unroll
        for (int h = 0; h < 8; ++h) {
            float d0 = __uint_as_float(a[h].x << 16) - lam * __uint_as_float(b[h].x << 16), d1 = __uint_as_float(a[h].x & 0xffff0000u) - lam * __uint_as_float(b[h].x & 0xffff0000u);
            float d2 = __uint_as_float(a[h].y << 16) - lam * __uint_as_float(b[h].y << 16), d3 = __uint_as_float(a[h].y & 0xffff0000u) - lam * __uint_as_float(b[h].y & 0xffff0000u);
            const float ss = wave_sum((d0 * d0 + d1 * d1) + (d2 * d2 + d3 * d3));
            const float r = post / sqrtf(ss * (1.f / 256.f) + RMS_EPS);
            u32x2 w; w.x = cvtpk2(d0 * r * gg.x, d1 * r * gg.y); w.y = cvtpk2(d2 * r * gg.z, d3 * r * gg.w);
            *((GAS u32x2*)(AO + (size_t)row * DM + h * 256) + lane) = w; }
    }
}
__device__ __forceinline__ void moba_gate_phase(const bf16* QKV, unsigned char* rowmask, LAS unsigned char* ldsb, int vcu, int G, int tid) {
    LAS float* part = (LAS float*)ldsb;
    LAS float* kmean = (LAS float*)(ldsb + 16384);
    for (int u = vcu; u < 512; u += G) {
        const int r = u >> 8, uu = u & 255, b = uu >> 6, h = (uu >> 2) & 15, x = uu & 3, own = r ? 7 - x : x;
        const bf16* Kb = QKV + (size_t)b * SEQ * NA_IN + 2048 + h * 128;
        const int rg = tid >> 4, cc = (tid & 15) * 8;
        for (int n = 0; n < own; ++n) {
            float s[8] = {0.f, 0.f, 0.f, 0.f, 0.f, 0.f, 0.f, 0.f};
#pragma unroll
            for (int i = 0; i < 8; ++i) { const v4u kv = *(const GAS v4u*)(Kb + (size_t)(n * 256 + rg + 32 * i) * NA_IN + cc);
                s[0] += __uint_as_float(kv.x << 16); s[1] += __uint_as_float(kv.x & 0xffff0000u); s[2] += __uint_as_float(kv.y << 16); s[3] += __uint_as_float(kv.y & 0xffff0000u);
                s[4] += __uint_as_float(kv.z << 16); s[5] += __uint_as_float(kv.z & 0xffff0000u); s[6] += __uint_as_float(kv.w << 16); s[7] += __uint_as_float(kv.w & 0xffff0000u); }
#pragma unroll
            for (int k = 0; k < 8; ++k) part[rg * 128 + cc + k] = s[k];
            __syncthreads();
            if (tid < 128) { float t = 0.f;
#pragma unroll 8
                for (int i = 0; i < 32; ++i) t += part[i * 128 + tid];
                kmean[n * 128 + tid] = t * (1.f / 256.f); }
            __syncthreads();
        }
        const int q = tid >> 1, half = tid & 1;
        const size_t qrow = (size_t)b * SEQ + own * 256 + q;
        const bf16* qp = QKV + qrow * NA_IN + h * 128 + half * 64;
        float qv[64];
#pragma unroll
        for (int i = 0; i < 8; ++i) { const v4u kv = *(const GAS v4u*)(qp + 8 * i);
            qv[8 * i + 0] = __uint_as_float(kv.x << 16); qv[8 * i + 1] = __uint_as_float(kv.x & 0xffff0000u); qv[8 * i + 2] = __uint_as_float(kv.y << 16); qv[8 * i + 3] = __uint_as_float(kv.y & 0xffff0000u);
            qv[8 * i + 4] = __uint_as_float(kv.z << 16); qv[8 * i + 5] = __uint_as_float(kv.z & 0xffff0000u); qv[8 * i + 6] = __uint_as_float(kv.w << 16); qv[8 * i + 7] = __uint_as_float(kv.w & 0xffff0000u); }
        float gt[7];
#pragma unroll
        for (int n = 0; n < 7; ++n) { float acc = 0.f;
            if (n < own) {
#pragma unroll
                for (int d4 = 0; d4 < 16; ++d4) { const f32x4 km = *(const LAS f32x4*)(kmean + n * 128 + half * 64 + 4 * d4);
                    acc = fmaf(qv[4 * d4 + 0], km.x, acc); acc = fmaf(qv[4 * d4 + 1], km.y, acc); acc = fmaf(qv[4 * d4 + 2], km.z, acc); acc = fmaf(qv[4 * d4 + 3], km.w, acc); } }
            acc += swz_xor<1>(acc); gt[n] = acc; }
        unsigned m = 0u;
#pragma unroll
        for (int k = 0; k < 3; ++k) { int best = -1; float bv = -__builtin_inff();
#pragma unroll
            for (int n = 0; n < 7; ++n) if (n < own && !((m >> n) & 1u) && gt[n] > bv) { bv = gt[n]; best = n; }
            if (best >= 0) m |= 1u << best; }
        m |= 1u << own;
        if (half == 0) rowmask[qrow * 16 + h] = (unsigned char)m;
        __syncthreads();
    }
}
__device__ __forceinline__ void dsa_index_phase(const bf16* QKV, unsigned* selbits, int gw, int ngw, int lane) {
    typedef short bf16x8 __attribute__((ext_vector_type(8)));
    const int c = lane & 31, hi = lane >> 5;
    for (int id = gw; id < 4096; id += ngw) {
        const int rnd = id / ngw, b = id >> 10, j0 = id & 1023, tp = (rnd & 1) ? 1023 - j0 : j0;
        const size_t row0 = (size_t)b * SEQ + 2 * tp;
        const int ntile = (2 * tp + 1) / 32 + 1, t_me = 2 * tp + hi;
        const int qq = (c >> 2) & 1, head = (c & 3) + 4 * (c >> 3);
        const bf16* ap = QKV + (row0 + qq) * NC_IN_PAD + 3072 + head * 64 + 8 * hi;
        bf16x8 a[4];
#pragma unroll
        for (int s = 0; s < 4; ++s) a[s] = *(const bf16x8*)(ap + 16 * s);
        float wf[16];
        { const bf16* wp = QKV + (row0 + hi) * NC_IN_PAD + 4160; const v4u w0 = *(const GAS v4u*)wp, w1 = *(const GAS v4u*)(wp + 8);
          const unsigned ww[8] = {w0.x, w0.y, w0.z, w0.w, w1.x, w1.y, w1.z, w1.w};
#pragma unroll
          for (int i = 0; i < 8; ++i) { wf[2 * i] = __uint_as_float(ww[i] << 16) * 0.03125f; wf[2 * i + 1] = __uint_as_float(ww[i] & 0xffff0000u) * 0.03125f; } }
        const bf16* kp = QKV + ((size_t)b * SEQ + c) * NC_IN_PAD + 4096 + 8 * hi;
        unsigned u[64];
#pragma unroll
        for (int j = 0; j < 64; ++j) {
            float sc = -__builtin_inff();
            if (j < ntile) {
                bf16x8 bb[4];
#pragma unroll
                for (int s = 0; s < 4; ++s) bb[s] = *(const bf16x8*)(kp + (size_t)j * 32 * NC_IN_PAD + 16 * s);
                f32x16 acc = {};
#pragma unroll
                for (int s = 0; s < 4; ++s) acc = __builtin_amdgcn_mfma_f32_32x32x16_bf16(a[s], bb[s], acc, 0, 0, 0);
                float v = 0.f;
#pragma unroll
                for (int r = 0; r < 16; ++r) v = fmaf(wf[r], fmaxf(acc[r], 0.f), v);
                if (32 * j + c <= t_me) sc = v;
            }
            const unsigned bits = __float_as_uint(sc);
            u[j] = bits ^ ((unsigned)((int)bits >> 31) | 0x80000000u);
        }
        unsigned T = 0u;
        for (int bit = 31; bit >= 0; --bit) {
            const unsigned cand = T | (1u << bit); int cnt = 0;
#pragma unroll
            for (int j = 0; j < 64; ++j) cnt += (u[j] >= cand) ? 1 : 0;
            cnt += swz_xor_i<1>(cnt); cnt += swz_xor_i<2>(cnt); cnt += swz_xor_i<4>(cnt); cnt += swz_xor_i<8>(cnt); cnt += swz_xor_i<16>(cnt);
            if (cnt >= 256) T = cand;
        }
        if (T < 0x00800000u) T = 0x00800000u;
        unsigned mylo = 0u, myhi = 0u;
#pragma unroll
        for (int j = 0; j < 64; ++j) { const unsigned long long bal = __ballot(u[j] >= T); if (lane == j) { mylo = (unsigned)bal; myhi = (unsigned)(bal >> 32); } }
        selbits[row0 * 64 + lane] = mylo; selbits[(row0 + 1) * 64 + lane] = myhi;
    }
}
constexpr int N_PHASES = 1 + 13 * DEPTH;
__device__ __forceinline__ const void* karg_ptr(unsigned off) {
    asm volatile("" : "+s"(off));
    const __attribute__((address_space(4))) char* ka = (const __attribute__((address_space(4))) char*)__builtin_amdgcn_kernarg_segment_ptr();
    return *(const void* const __attribute__((address_space(4)))*)(ka + off);
}
#define KIN(i) ((const float*)karg_ptr(8u * (i)))
#define KOUT() ((float*)karg_ptr(168u))
#define KWS() ((unsigned char*)karg_ptr(176u))
static_assert(offsetof(Args, out) == 168 && offsetof(Args, ws) == 176 && offsetof(Args, ph_lo) == 184 && offsetof(Args, ph_hi) == 188 && sizeof(Args) == 192, "Args layout");
#define TIDS() int tid = threadIdx.x; asm volatile("" : "+v"(tid)); const int lane = tid & 63, wave = __builtin_amdgcn_readfirstlane(tid >> 6), gw = vcu * NWAVES + wave, ngw = G * NWAVES; (void)lane; (void)gw; (void)ngw
__global__ void __launch_bounds__(NWAVES * 64, 2) mega_fwd(Args args) {
    extern __shared__ __attribute__((aligned(16))) unsigned char lds[];
    LAS unsigned char* const ldsl = (LAS unsigned char*)lds;
    const int G = gridDim.x, bx = blockIdx.x, vcu = (G % 8 == 0) ? (bx % 8) * (G / 8) + bx / 8 : bx;
    { volatile LAS unsigned* const MISC0 = (volatile LAS unsigned*)(ldsl + LDSCTL_OFF);
      for (int u = threadIdx.x; u < (LDS_BYTES - LDSCTL_OFF) / 4; u += NWAVES * 64) MISC0[u] = 0u; }
    __syncthreads();
    XcdBarrier bar = xcd_barrier_post((unsigned*)((gu32*)(KWS() + WS_CTL) + CW_BAR), (volatile LAS unsigned*)(ldsl + MISC_OFF) + 8);
    int pc = 0; const int lo = args.ph_lo, hi = args.ph_hi;
#define RUN (pc >= lo && pc < hi)
#define SEAM() do { if (pc >= lo && pc + 1 < hi) xcd_barrier(bar); ++pc; } while (0)

    if (RUN) {
        TIDS(); unsigned char* const ws = KWS();
        LAS float* scr = (LAS float*)(ldsl + RING_OFF + wave * 16384);
        for (int mi = 0; mi < N_WMATS; ++mi) { const WDesc d = wdesc(ws, mi); const int nitems = (d.K / 64) * (d.Npad / 32);
            for (int it = gw; it < nitems; it += ngw) transpose_item(d, scr, it, lane); }
        cvt_rows(KIN(0), (bf16*)(ws + WS_XB), (size_t)T_TOK * DM, gw * 64 + lane, ngw * 64);
        cvt_rows(KIN(1), (bf16*)(ws + WS_PB), (size_t)DEPTH * T_TOK * PLE, gw * 64 + lane, ngw * 64);
    }
    SEAM();

    const int G0 = G, bx0 = bx, vcu0 = vcu; const XcdBarrier bar0 = bar;
    for (int hl = 0; hl < 2 * DEPTH; ++hl) {
        int G = G0, bx = bx0, vcu = vcu0; XcdBarrier bar = bar0;
        asm volatile("" : "+s"(G), "+s"(bx), "+s"(vcu), "+s"(bar.bar), "+s"(bar.x), "+s"(bar.st));
        const int layer = hl >> 1, second = hl & 1, mix = layer % 3, mj = layer / 3;
        if (RUN) {
            unsigned char* const ws = KWS(); unsigned char* const lw = ws + WS_W + (size_t)layer * LW_BYTES;
            pg8::Gemm g{(const bf16*)(ws + WS_XB), (const bf16*)(lw + (second ? LW_F2IN : LW_F1IN)), T_TOK, 2 * FF, DM}; pg8::StaticOrder S; S.init(T_TOK, 2 * FF, G, bx);
            pg8::EpiSwiGLU E{(bf16*)(ws + WS_H), FF};
            pg8::gemm_phase<pg8::EpiSwiGLU, pg8::StaticOrder, PG8_ALIGN, PG8_SP2>(ldsl + RING_OFF, g, S, E);
        }
        SEAM();
        if (RUN) {
            unsigned char* const ws = KWS(); unsigned char* const lw = ws + WS_W + (size_t)layer * LW_BYTES;
            const float* const resid0 = (hl == 0) ? KIN(0) : (const float*)(ws + WS_X);
            pg8::Gemm g{(const bf16*)(ws + WS_H), (const bf16*)(lw + (second ? LW_F2OUT : LW_F1OUT)), T_TOK, DM, FF}; pg8::StaticOrder S; S.init(T_TOK, DM, G, bx);
            pg8::EpiZ E{resid0, (float*)(ws + WS_Z), DM, ALPHA, 0.5f};
            pg8::gemm_phase<pg8::EpiZ, pg8::StaticOrder, PG8_ALIGN, PG8_SP2>(ldsl + RING_OFF, g, S, E);
        }
        SEAM();
        if (RUN) { TIDS(); unsigned char* const ws = KWS(); const size_t lo_ = ((size_t)layer * 4 + (second ? 2 : 0)) * DM;
            ln_phase((const float*)(ws + WS_Z), KIN(6) + lo_, KIN(7) + lo_, (float*)(ws + WS_X), (bf16*)(ws + WS_XB), gw, ngw, lane); }
        SEAM();
        if (!second) {
            const int n_in = (mix == 2) ? NC_IN_PAD : NA_IN;
            if (RUN) {
                unsigned char* const ws = KWS(); unsigned char* const mb = ws + WS_MIX;
                const bf16* const w_in = (const bf16*)(mix == 0 ? mb + (size_t)mj * MW_A_STRIDE + MW_A_IN : mix == 1 ? mb + MW_B_IN : mb + MW_C_IN);
                { pg8::Gemm g{(const bf16*)(ws + WS_XB), w_in, T_TOK, n_in, DM}; pg8::StaticOrder S; S.init(T_TOK, n_in, G, bx);
                  pg8::EpiBf16<0> E{(bf16*)(ws + WS_QKV), n_in, nullptr, 0, 0, 1.f};
                  pg8::gemm_phase<pg8::EpiBf16<0>, pg8::StaticOrder, PG8_ALIGN, PG8_SP2>(ldsl + RING_OFF, g, S, E); }
                { pg8::Gemm g{(const bf16*)(ws + WS_PB) + (size_t)layer * T_TOK * PLE, (const bf16*)(ws + WS_W + (size_t)layer * LW_BYTES + LW_PP), T_TOK, DM, PLE}; pg8::StaticOrder S; S.init(T_TOK, DM, G, bx);
                  pg8::EpiF32 E{(float*)(ws + WS_PP), DM};
                  pg8::gemm_phase<pg8::EpiF32, pg8::StaticOrder, PG8_ALIGN, PG8_SP2>(ldsl + RING_OFF, g, S, E); }
            }
            SEAM();
            if (mix == 0) {
                if (RUN) { unsigned char* const ws = KWS();
                    att::attn_phase<0>((char*)lds + RING_OFF, (const bf16*)(ws + WS_QKV), NA_IN, (bf16*)(ws + WS_OP), 4096, ws + WS_RM, (const unsigned*)(ws + WS_SEL), 32, bx, G); }
                SEAM();
                if (RUN) { TIDS(); unsigned char* const ws = KWS();
                    diff_combine_phase((const bf16*)(ws + WS_OP), (bf16*)(ws + WS_AO), KIN(12) + mj * 128, KIN(13) + mj * 128, KIN(14) + mj * 128, KIN(15) + mj * 128, KIN(16) + mj * 256,
                                       0.8f - 0.6f * expf(-0.3f * (float)layer), gw, ngw, lane); }
                SEAM();
            } else if (mix == 1) {
                if (RUN) { TIDS(); unsigned char* const ws = KWS(); moba_gate_phase((const bf16*)(ws + WS_QKV), ws + WS_RM, ldsl + RING_OFF, vcu, G, tid); }
                SEAM();
                if (RUN) { unsigned char* const ws = KWS();
                    att::attn_phase<1>((char*)lds + RING_OFF, (const bf16*)(ws + WS_QKV), NA_IN, (bf16*)(ws + WS_AO), DM, ws + WS_RM, (const unsigned*)(ws + WS_SEL), 16, bx, G); }
                SEAM();
            } else {
                if (RUN) { TIDS(); unsigned char* const ws = KWS(); dsa_index_phase((const bf16*)(ws + WS_QKV), (unsigned*)(ws + WS_SEL), gw, ngw, lane); }
                SEAM();
                if (RUN) { unsigned char* const ws = KWS();
                    att::attn_phase<2>((char*)lds + RING_OFF, (const bf16*)(ws + WS_QKV), NC_IN_PAD, (bf16*)(ws + WS_AO), DM, ws + WS_RM, (const unsigned*)(ws + WS_SEL), 16, bx, G); }
                SEAM();
            }
            if (RUN) {
                unsigned char* const ws = KWS(); unsigned char* const mb = ws + WS_MIX;
                const bf16* const w_out = (const bf16*)(mix == 0 ? mb + (size_t)mj * MW_A_STRIDE + MW_A_OUT : mix == 1 ? mb + MW_B_OUT : mb + MW_C_OUT);
                pg8::Gemm g{(const bf16*)(ws + WS_AO), w_out, T_TOK, DM, DM}; pg8::StaticOrder S; S.init(T_TOK, DM, G, bx);
                pg8::EpiZ E{(const float*)(ws + WS_X), (float*)(ws + WS_Z), DM, ALPHA, 1.0f};
                pg8::gemm_phase<pg8::EpiZ, pg8::StaticOrder, PG8_ALIGN, PG8_SP2>(ldsl + RING_OFF, g, S, E);
            }
            SEAM();
            if (RUN) { TIDS(); unsigned char* const ws = KWS(); const size_t lo_ = ((size_t)layer * 4 + 1) * DM;
                ln_phase((const float*)(ws + WS_Z), KIN(6) + lo_, KIN(7) + lo_, (float*)(ws + WS_X), (bf16*)(ws + WS_XB), gw, ngw, lane); }
            SEAM();
        } else {
            if (RUN) {
                unsigned char* const ws = KWS();
                pg8::Gemm g{(const bf16*)(ws + WS_XB), (const bf16*)(ws + WS_W + (size_t)layer * LW_BYTES + LW_PG), T_TOK, DM, DM}; pg8::StaticOrder S; S.init(T_TOK, DM, G, bx);
                pg8::EpiPle E{(const float*)(ws + WS_X), (const float*)(ws + WS_PP), (float*)(ws + WS_Z), DM, ALPHA};
                pg8::gemm_phase<pg8::EpiPle, pg8::StaticOrder, PG8_ALIGN, PG8_SP2>(ldsl + RING_OFF, g, S, E);
            }
            SEAM();
            if (RUN) { TIDS(); unsigned char* const ws = KWS(); const size_t lo_ = ((size_t)layer * 4 + 3) * DM; const bool fin = layer == DEPTH - 1;
                ln_phase((const float*)(ws + WS_Z), KIN(6) + lo_, KIN(7) + lo_, fin ? KOUT() : (float*)(ws + WS_X), fin ? (bf16*)nullptr : (bf16*)(ws + WS_XB), gw, ngw, lane); }
            SEAM();
        }
    }
#undef RUN
#undef SEAM
}

extern "C" void kernel_launch(void* const* d_in, const int* in_sizes, int n_in, void* d_out, int out_size, void* d_ws, size_t ws_size, hipStream_t stream) {
    static int grid = 0;
    if (grid == 0) {
        if (n_in != 21 || in_sizes[0] != T_TOK * DM || out_size != T_TOK * DM || ws_size < WS_END) {
            fprintf(stderr, "kernel_launch: shape/workspace mismatch (n_in %d, in0 %d, out %d, ws %zu, need %zu); nothing launched\n", n_in, n_in > 0 ? in_sizes[0] : -1, out_size, ws_size, (size_t)WS_END); grid = -1; return; }
        int dev = 0, cus = 0, per_cu = 0;
        if (hipGetDevice(&dev) != hipSuccess || hipDeviceGetAttribute(&cus, hipDeviceAttributeMultiprocessorCount, dev) != hipSuccess) { fprintf(stderr, "kernel_launch: device query failed\n"); grid = -1; return; }
        if (hipFuncSetAttribute((const void*)mega_fwd, hipFuncAttributeMaxDynamicSharedMemorySize, LDS_BYTES) != hipSuccess) { fprintf(stderr, "kernel_launch: hipFuncSetAttribute failed\n"); grid = -1; return; }
        if (hipOccupancyMaxActiveBlocksPerMultiprocessor(&per_cu, (const void*)mega_fwd, NWAVES * 64, LDS_BYTES) != hipSuccess || per_cu < 1)
            fprintf(stderr, "kernel_launch: note: occupancy query reports %d workgroups per CU\n", per_cu);
        (void)hipGetLastError();
        grid = cus;
    }
    if (grid < 0) return;
    if (hipMemsetAsync((char*)d_ws + WS_CTL, 0, CTL_ZERO_BYTES, stream) != hipSuccess) { fprintf(stderr, "kernel_launch: memset failed\n"); return; }
    Args a{};
    for (int i = 0; i < 21; ++i) a.in[i] = (const float*)d_in[i];
    a.out = (float*)d_out; a.ws = (unsigned char*)d_ws;
#if MK_PER_PHASE
    for (int p = 0; p < N_PHASES; ++p) { a.ph_lo = p; a.ph_hi = p + 1; hipLaunchKernelGGL(mega_fwd, dim3(grid), dim3(NWAVES * 64), LDS_BYTES, stream, a); }
#else
    a.ph_lo = 0; a.ph_hi = N_PHASES;
    hipLaunchKernelGGL(mega_fwd, dim3(grid), dim3(NWAVES * 64), LDS_BYTES, stream, a);
#endif
    const hipError_t le = hipPeekAtLastError();
    if (le != hipSuccess) fprintf(stderr, "kernel_launch: launch failed: %s\n", hipGetErrorName(le));
}
```

```cpp
#include <hip/hip_runtime.h>
#include <cstdio>
#include <cstdint>
namespace pg8 {
#define PG8_LAS __attribute__((address_space(3)))
typedef unsigned short bf16_t;
typedef short bf16x8 __attribute__((ext_vector_type(8)));
typedef float f32x4 __attribute__((ext_vector_type(4)));
typedef unsigned u32x4 __attribute__((ext_vector_type(4)));
constexpr int BM = 256, BK = 64, HALF = 128, HTB = HALF * BK * 2  , STAGE_BYTES = 8 * HTB, NXCD = 8, WGM = 8;

__host__ __device__ __forceinline__ int lds_byte(int r, int c) { const int st = (r >> 4) * 2 + (c >> 5), rr = r & 15, cc = c & 31, ob = rr * 64 + cc * 2; return st * 1024 + (ob ^ (((ob >> 9) & 1) << 5)); }
__host__ __device__ __forceinline__ void stage_rc(int b, int& R, int& C) { const int st = b / 1024, sb = b % 1024, swz = sb ^ (((sb >> 9) & 1) << 5); R = (st >> 1) * 16 + swz / 64; C = (st & 1) * 32 + (swz % 64) / 2; }
__host__ __device__ __forceinline__ int perm32(int rho) { const int n = rho >> 4, i = rho & 15; return 8 * (i >> 2) + 4 * n + (i & 3); }

struct Unit { int pm, pn; };
struct Gemm { const bf16_t* A; const bf16_t* Bt; int M, N, K; };

struct StaticOrder {
    int nM, nN, nwg, G, c;
    __host__ __device__ void init(int M, int N, int G_, int c_) { nM = M / BM; nN = N / BM; nwg = nM * nN; G = G_; c = c_; }
    __host__ __device__ bool next(int i, Unit& u) const {
        const long L = (long)i * G + c; if (L >= nwg) return false;
        int wgid = (int)L; { const int q = nwg / NXCD, r = nwg % NXCD, xcd = wgid % NXCD, off = wgid / NXCD; wgid = (xcd < r ? xcd * (q + 1) : r * (q + 1) + (xcd - r) * q) + off; }
        const int nig = WGM * nN, gid = wgid / nig, fm = gid * WGM, gsz = (nM - fm) < WGM ? (nM - fm) : WGM;
        u.pm = fm + ((wgid % nig) % gsz); u.pn = (wgid % nig) / gsz; return true;
    }
    __device__ __forceinline__ void a_ready(const Unit&) const {}
    __device__ __forceinline__ void done(const Unit&) const {}
};

__device__ __forceinline__ unsigned cvt_pk_bf16(float lo, float hi) { unsigned r; asm volatile("v_cvt_pk_bf16_f32 %0, %1, %2" : "=v"(r) : "v"(lo), "v"(hi)); return r; }
typedef float f32x2 __attribute__((ext_vector_type(2)));
__device__ __forceinline__ f32x2 gelu_pk(f32x2 v) {
    const f32x2 av = __builtin_elementwise_abs(v), d = av * 0.2316418882f + 1.0f;
    f32x2 t; t.x = __builtin_amdgcn_rcpf(d.x); t.y = __builtin_amdgcn_rcpf(d.y);
    f32x2 q = t * 0.5307027145f + (-0.7265760135f); q = q * t + 0.7107068705f; q = q * t + (-0.142248368f); q = q * t + 0.127414796f; q = q * t;
    const f32x2 s = (v * v) * (-0.72134752044f);
    f32x2 e; e.x = __builtin_amdgcn_exp2f(s.x); e.y = __builtin_amdgcn_exp2f(s.y);
    const f32x2 m = v * (q * e), r = v - m;
    f32x2 o; o.x = v.x < 0.f ? m.x : r.x; o.y = v.y < 0.f ? m.y : r.y; return o;
}

template <int ACT  > struct EpiBf16 {
    static constexpr bool PERM = true, AFTER_DRAIN = false; static_assert(ACT == 0 || ACT == 1, "EpiBf16: ACT is 0 (none) or 1 (gelu_pk)");
    bf16_t* O; int ldc; const float* bias; int split_cols; size_t split_stride; float scale0;
    __device__ __forceinline__ void operator()(const f32x4 (&acc)[2][2][4][2], const Unit& u, int wr, int wc, int fr, int fq) const {
        const int row0 = u.pm * BM + wr * 64 + fr; int colt = u.pn * BM; bf16_t* base = O;
        float sc = 1.f; if (split_cols) { const int t = colt / split_cols; base += (size_t)t * split_stride; colt -= t * split_cols; if (t == 0) sc = scale0; }
        const int col0 = colt + wc * 32 + 8 * fq, bcol0 = u.pn * BM + wc * 32 + 8 * fq;
        f32x4 bv[2][2];
#pragma unroll
        for (int bj = 0; bj < 2; ++bj)
#pragma unroll
            for (int n = 0; n < 2; ++n) bv[bj][n] = bias ? *(const f32x4*)(bias + bcol0 + bj * HALF + 4 * n) : (f32x4){0.f, 0.f, 0.f, 0.f};
#pragma unroll
        for (int ai = 0; ai < 2; ++ai)
#pragma unroll
            for (int m = 0; m < 4; ++m) { bf16_t* rowp = base + (size_t)(row0 + ai * HALF + m * 16) * ldc + col0;
#pragma unroll
                for (int bj = 0; bj < 2; ++bj) { f32x4 v0 = acc[ai][bj][m][0] + bv[bj][0], v1 = acc[ai][bj][m][1] + bv[bj][1];
                    if (ACT == 1) { f32x2 a = gelu_pk((f32x2){v0[0], v0[1]}), b = gelu_pk((f32x2){v0[2], v0[3]}), c = gelu_pk((f32x2){v1[0], v1[1]}), d = gelu_pk((f32x2){v1[2], v1[3]});
                        v0 = (f32x4){a.x, a.y, b.x, b.y}; v1 = (f32x4){c.x, c.y, d.x, d.y}; }
                    v0 = v0 * sc; v1 = v1 * sc; u32x4 w; w.x = cvt_pk_bf16(v0[0], v0[1]); w.y = cvt_pk_bf16(v0[2], v0[3]); w.z = cvt_pk_bf16(v1[0], v1[1]); w.w = cvt_pk_bf16(v1[2], v1[3]);
                    *(u32x4*)(rowp + bj * HALF) = w; } }
    }
};

struct EpiF32 {
    static constexpr bool PERM = false, AFTER_DRAIN = false;
    float* C; int ldc;
    __device__ __forceinline__ void operator()(const f32x4 (&acc)[2][2][4][2], const Unit& u, int wr, int wc, int fr, int fq) const {
        const int row0 = u.pm * BM + wr * 64 + fr, col0 = u.pn * BM + wc * 32 + 4 * fq;
#pragma unroll
        for (int ai = 0; ai < 2; ++ai)
#pragma unroll
            for (int m = 0; m < 4; ++m) { float* rowp = C + (size_t)(row0 + ai * HALF + m * 16) * ldc + col0;
#pragma unroll
                for (int bj = 0; bj < 2; ++bj)
#pragma unroll
                    for (int n = 0; n < 2; ++n) *(f32x4*)(rowp + bj * HALF + n * 16) = acc[ai][bj][m][n]; }
    }
};
struct EpiZ {
    static constexpr bool PERM = false, AFTER_DRAIN = false;
    const float* resid; float* Z; int ldc; float alpha, s;
    __device__ __forceinline__ void operator()(const f32x4 (&acc)[2][2][4][2], const Unit& u, int wr, int wc, int fr, int fq) const {
        const int row0 = u.pm * BM + wr * 64 + fr, col0 = u.pn * BM + wc * 32 + 4 * fq;
#pragma unroll
        for (int ai = 0; ai < 2; ++ai)
#pragma unroll
            for (int m = 0; m < 4; ++m) { const size_t off = (size_t)(row0 + ai * HALF + m * 16) * ldc + col0;
#pragma unroll
                for (int bj = 0; bj < 2; ++bj)
#pragma unroll
                    for (int n = 0; n < 2; ++n) { const f32x4 x = *(const f32x4*)(resid + off + bj * HALF + n * 16);
                        *(f32x4*)(Z + off + bj * HALF + n * 16) = x * alpha + acc[ai][bj][m][n] * s; }
                if (m & 1) asm volatile("" ::: "memory"); }
    }
};
struct EpiPle {
    static constexpr bool PERM = false, AFTER_DRAIN = false;
    const float* resid; const float* pp; float* Z; int ldc; float alpha;
    __device__ __forceinline__ void operator()(const f32x4 (&acc)[2][2][4][2], const Unit& u, int wr, int wc, int fr, int fq) const {
        const int row0 = u.pm * BM + wr * 64 + fr, col0 = u.pn * BM + wc * 32 + 4 * fq;
#pragma unroll
        for (int ai = 0; ai < 2; ++ai)
#pragma unroll
            for (int m = 0; m < 4; ++m) { const size_t off = (size_t)(row0 + ai * HALF + m * 16) * ldc + col0;
#pragma unroll
                for (int bj = 0; bj < 2; ++bj)
#pragma unroll
                    for (int n = 0; n < 2; ++n) { const f32x4 x = *(const f32x4*)(resid + off + bj * HALF + n * 16); const f32x4 p = *(const f32x4*)(pp + off + bj * HALF + n * 16);
                        const f32x4 a = acc[ai][bj][m][n]; f32x4 sg;
#pragma unroll
                        for (int e = 0; e < 4; ++e) sg[e] = __builtin_amdgcn_rcpf(1.0f + __builtin_amdgcn_exp2f(a[e] * -1.4426950408889634f));
                        *(f32x4*)(Z + off + bj * HALF + n * 16) = x * alpha + sg * p; }
                if (m & 1) asm volatile("" ::: "memory"); }
    }
};
struct EpiSwiGLU {
    static constexpr bool PERM = true, AFTER_DRAIN = false;
    bf16_t* O; int ldc;
    __device__ __forceinline__ void operator()(const f32x4 (&acc)[2][2][4][2], const Unit& u, int wr, int wc, int fr, int fq) const {
        const int row0 = u.pm * BM + wr * 64 + fr, col0 = u.pn * HALF + wc * 32 + 8 * fq;
#pragma unroll
        for (int ai = 0; ai < 2; ++ai)
#pragma unroll
            for (int m = 0; m < 4; ++m) { bf16_t* rowp = O + (size_t)(row0 + ai * HALF + m * 16) * ldc + col0;
                f32x4 h[2];
#pragma unroll
                for (int n = 0; n < 2; ++n) { const f32x4 g = acc[ai][0][m][n], up = acc[ai][1][m][n];
#pragma unroll
                    for (int e = 0; e < 4; ++e) h[n][e] = g[e] * __builtin_amdgcn_rcpf(1.0f + __builtin_amdgcn_exp2f(g[e] * -1.4426950408889634f)) * up[e]; }
                u32x4 w; w.x = cvt_pk_bf16(h[0][0], h[0][1]); w.y = cvt_pk_bf16(h[0][2], h[0][3]); w.z = cvt_pk_bf16(h[1][0], h[1][1]); w.w = cvt_pk_bf16(h[1][2], h[1][3]);
                *(u32x4*)rowp = w; }
    }
};
template <class Epi, class Sched, bool ALIGN_EPI = false, bool SP2 = false>
__device__ __forceinline__ void gemm_phase(PG8_LAS unsigned char* lds, const Gemm g, const Sched& S, const Epi& E) {
    int tid = threadIdx.x; asm volatile("" : "+v"(tid));
    const int wid = __builtin_amdgcn_readfirstlane(tid >> 6), lane = tid & 63, wr = wid >> 2, wc = wid & 3, fr = lane & 15, fq = lane >> 4;
    const int K = g.K, nt = K / BK;
    unsigned voffA[2], voffB[2];
#pragma unroll
    for (int i = 0; i < 2; ++i) { int R, C; stage_rc(tid * 16 + i * 8192, R, C); const int Rb = Epi::PERM ? ((R & ~31) + perm32(R & 31)) : R;
        voffA[i] = (unsigned)(R * K + C) * 2u; voffB[i] = (unsigned)(Rb * K + C) * 2u; }
    const size_t kstep = (size_t)(BK * 2);
    const size_t hstep = (size_t)HALF * K * 2;
    const size_t tstep = 2 * hstep;
    const unsigned ldsw = (unsigned)wid * 1024u;
    const int aoff = lds_byte(wr * 64 + fr, fq * 8), boff = lds_byte(wc * 32 + fr, fq * 8);
#define PG8_SA(b, h) (((b) * 2 + (h)) * HTB)
#define PG8_SB(b, h) ((4 + (b) * 2 + (h)) * HTB)
#define PG8_STAGE(bufoff, gbase, voff) do { _Pragma("unroll") for (int _i = 0; _i < 2; ++_i) \
        __builtin_amdgcn_global_load_lds((const unsigned*)((const char*)(gbase) + (voff)[_i]), (PG8_LAS unsigned*)(lds + (bufoff) + ldsw + _i * 8192), 16, 0, 0); } while (0)
#define PG8_LDA(dst, b, h) do { _Pragma("unroll") for (int m = 0; m < 4; ++m) _Pragma("unroll") for (int k = 0; k < 2; ++k) dst[m][k] = *(const PG8_LAS bf16x8*)(lds + PG8_SA(b, h) + aoff + m * 2048 + k * 1024); } while (0)
#define PG8_LDB(dst, b, h) do { _Pragma("unroll") for (int n = 0; n < 2; ++n) _Pragma("unroll") for (int k = 0; k < 2; ++k) dst[n][k] = *(const PG8_LAS bf16x8*)(lds + PG8_SB(b, h) + boff + n * 2048 + k * 1024); } while (0)
#define PG8_MMA(ai, bj, At, Bt) do { __builtin_amdgcn_s_setprio(1); _Pragma("unroll") for (int m = 0; m < 4; ++m) _Pragma("unroll") for (int n = 0; n < 2; ++n) _Pragma("unroll") for (int k = 0; k < 2; ++k) \
        acc[ai][bj][m][n] = __builtin_amdgcn_mfma_f32_16x16x32_bf16(Bt[n][k], At[m][k], acc[ai][bj][m][n], 0, 0, 0); __builtin_amdgcn_s_setprio(0); } while (0)
#define PG8_WAIT_V(n) asm volatile("s_waitcnt vmcnt(" #n ")" ::: "memory")
#define PG8_WAIT_L(n) asm volatile("s_waitcnt lgkmcnt(" #n ")" ::: "memory")
#define PG8_BAR __builtin_amdgcn_s_barrier()
#define PG8_SCHED __builtin_amdgcn_sched_barrier(0)
    Unit cur, nxt; int ui = 0;
    if (!S.next(0, cur)) return;
    f32x4 acc[2][2][4][2];
#pragma unroll
    for (int a = 0; a < 2; ++a)
#pragma unroll
        for (int b = 0; b < 2; ++b)
#pragma unroll
            for (int m = 0; m < 4; ++m)
#pragma unroll
                for (int n = 0; n < 2; ++n) acc[a][b][m][n] = (f32x4){0.f, 0.f, 0.f, 0.f};
    bf16x8 At[4][2], B0[2][2], B1[2][2];
    const char* cA = (const char*)g.A + (size_t)cur.pm * tstep; const char* cB = (const char*)g.Bt + (size_t)cur.pn * tstep;
    S.a_ready(cur);
    if constexpr (SP2) {
        PG8_STAGE(PG8_SB(0, 0), cB, voffB); PG8_STAGE(PG8_SB(0, 1), cB + hstep, voffB); PG8_STAGE(PG8_SA(0, 0), cA, voffA); PG8_STAGE(PG8_SA(0, 1), cA + hstep, voffA);
        if (wr == 1) PG8_BAR;
        PG8_WAIT_V(2); PG8_BAR;
        PG8_STAGE(PG8_SB(1, 0), cB + kstep, voffB); PG8_STAGE(PG8_SA(1, 0), cA + kstep, voffA); PG8_STAGE(PG8_SB(1, 1), cB + hstep + kstep, voffB);
        PG8_WAIT_V(6); PG8_BAR;
    } else {
        PG8_STAGE(PG8_SB(0, 0), cB, voffB); PG8_STAGE(PG8_SA(0, 0), cA, voffA); PG8_STAGE(PG8_SB(0, 1), cB + hstep, voffB); PG8_STAGE(PG8_SA(0, 1), cA + hstep, voffA);
        if (wr == 1) PG8_BAR;
        PG8_WAIT_V(4); PG8_BAR;
        PG8_STAGE(PG8_SB(1, 0), cB + kstep, voffB); PG8_STAGE(PG8_SA(1, 0), cA + kstep, voffA); PG8_STAGE(PG8_SB(1, 1), cB + hstep + kstep, voffB);
        PG8_WAIT_V(6); PG8_BAR;
    }
    for (;;) {
        const bool has_next = S.next(ui + 1, nxt);
        const char* nA = has_next ? (const char*)g.A + (size_t)nxt.pm * tstep : cA; const char* nB = has_next ? (const char*)g.Bt + (size_t)nxt.pn * tstep : cB;
        for (int t = 0; t < nt; t += 2) {
            const bool last = (t == nt - 2);
            const char* a1 = cA + (size_t)(t + 1) * kstep;
            const char* a2 = last ? nA : cA + (size_t)(t + 2) * kstep; const char* b2 = last ? nB : cB + (size_t)(t + 2) * kstep;
            const char* a3 = a2 + kstep; const char* b3 = b2 + kstep;
            if (last && has_next) S.a_ready(nxt);
            if constexpr (SP2) {
            PG8_LDB(B0, 0, 0); PG8_LDB(B1, 0, 1); PG8_SCHED; PG8_LDA(At, 0, 0); PG8_STAGE(PG8_SA(1, 1), a1 + hstep, voffA);
            PG8_WAIT_V(8); PG8_WAIT_L(0); PG8_BAR; PG8_MMA(0, 0, At, B0); PG8_MMA(0, 1, At, B1); PG8_BAR; PG8_SCHED;
            PG8_LDA(At, 0, 1); PG8_STAGE(PG8_SB(0, 0), b2, voffB); PG8_STAGE(PG8_SB(0, 1), b2 + hstep, voffB); PG8_STAGE(PG8_SA(0, 0), a2, voffA);
            PG8_WAIT_V(8); PG8_WAIT_L(0); PG8_BAR; PG8_MMA(1, 0, At, B0); PG8_MMA(1, 1, At, B1); PG8_BAR; PG8_SCHED;
            PG8_LDB(B0, 1, 0); PG8_LDB(B1, 1, 1); PG8_SCHED; PG8_LDA(At, 1, 0); PG8_STAGE(PG8_SA(0, 1), a2 + hstep, voffA);
            PG8_WAIT_V(8); PG8_WAIT_L(0); PG8_BAR; PG8_MMA(0, 0, At, B0); PG8_MMA(0, 1, At, B1); PG8_BAR; PG8_SCHED;
            PG8_LDA(At, 1, 1); PG8_STAGE(PG8_SB(1, 0), b3, voffB); PG8_STAGE(PG8_SB(1, 1), b3 + hstep, voffB); PG8_STAGE(PG8_SA(1, 0), a3, voffA);
            PG8_WAIT_V(8); PG8_WAIT_L(0); PG8_BAR; PG8_MMA(1, 0, At, B0); PG8_MMA(1, 1, At, B1); PG8_BAR; PG8_SCHED;
            } else {
            PG8_LDB(B0, 0, 0); PG8_SCHED; PG8_LDA(At, 0, 0); PG8_STAGE(PG8_SA(1, 1), a1 + hstep, voffA);
            PG8_WAIT_L(8); PG8_BAR; PG8_WAIT_L(0); PG8_MMA(0, 0, At, B0); PG8_BAR; PG8_SCHED;
            PG8_LDB(B1, 0, 1); PG8_STAGE(PG8_SB(0, 0), b2, voffB);
            PG8_BAR; PG8_WAIT_L(0); PG8_MMA(0, 1, At, B1); PG8_BAR;
            PG8_LDA(At, 0, 1); PG8_STAGE(PG8_SA(0, 0), a2, voffA);
            PG8_BAR; PG8_WAIT_L(0); PG8_MMA(1, 0, At, B0); PG8_BAR; PG8_SCHED;
            PG8_STAGE(PG8_SB(0, 1), b2 + hstep, voffB);
            PG8_WAIT_V(6); PG8_BAR; PG8_MMA(1, 1, At, B1); PG8_BAR;
            PG8_LDB(B0, 1, 0); PG8_SCHED; PG8_LDA(At, 1, 0); PG8_STAGE(PG8_SA(0, 1), a2 + hstep, voffA);
            PG8_WAIT_L(8); PG8_BAR; PG8_WAIT_L(0); PG8_MMA(0, 0, At, B0); PG8_BAR; PG8_SCHED;
            PG8_LDB(B1, 1, 1); PG8_STAGE(PG8_SB(1, 0), b3, voffB);
            PG8_BAR; PG8_WAIT_L(0); PG8_MMA(0, 1, At, B1); PG8_BAR;
            PG8_LDA(At, 1, 1); PG8_STAGE(PG8_SA(1, 0), a3, voffA);
            PG8_BAR; PG8_WAIT_L(0); PG8_MMA(1, 0, At, B0); PG8_BAR; PG8_SCHED;
            PG8_STAGE(PG8_SB(1, 1), b3 + hstep, voffB);
            PG8_WAIT_V(6); PG8_BAR; PG8_MMA(1, 1, At, B1); PG8_BAR;
            }
        }
        if constexpr (ALIGN_EPI) { if (wr == 0) PG8_BAR; }
        if constexpr (!Epi::AFTER_DRAIN) { E(acc, cur, wr, wc, fr, fq); S.done(cur); }
        if (!has_next) break;
#pragma unroll
        for (int a = 0; a < 2; ++a)
#pragma unroll
            for (int b = 0; b < 2; ++b)
#pragma unroll
                for (int m = 0; m < 4; ++m)
#pragma unroll
                    for (int n = 0; n < 2; ++n) acc[a][b][m][n] = (f32x4){0.f, 0.f, 0.f, 0.f};
        cur = nxt; cA = nA; cB = nB; ++ui;
        if constexpr (ALIGN_EPI) { if (wr == 1) PG8_BAR; }
    }
    PG8_WAIT_V(0);
    if constexpr (!ALIGN_EPI) { if (wr == 0) PG8_BAR; }
    PG8_BAR;
    if constexpr (Epi::AFTER_DRAIN) { E.fused(acc, cur, wr, wc, fr, fq, lds, wid, lane); S.done(cur); }
#undef PG8_SA
#undef PG8_SB
#undef PG8_STAGE
#undef PG8_LDA
#undef PG8_LDB
#undef PG8_MMA
#undef PG8_WAIT_V
#undef PG8_WAIT_L
#undef PG8_BAR
#undef PG8_SCHED
}
}
namespace att {
typedef unsigned short bf16;
typedef short bf16x8 __attribute__((ext_vector_type(8)));
typedef short s16x4 __attribute__((ext_vector_type(4)));
typedef float f32x16 __attribute__((ext_vector_type(16)));
typedef float f32x4 __attribute__((ext_vector_type(4)));
typedef unsigned u32x4 __attribute__((ext_vector_type(4)));
typedef unsigned u32x2 __attribute__((ext_vector_type(2)));
constexpr float SCALE = 0.08838834764831845f;
constexpr float THR = 8.f;
constexpr int NW = 8, QBLK = 32, KVBLK = 64, QB = NW * QBLK, D = 128;
constexpr int SHM_V = KVBLK * D * 2, SHM_K = KVBLK * D * 2;
constexpr int LDS_BYTES = 2 * SHM_V + 2 * SHM_K + NW * 64 * 4;
#define KSWZ(row, colB) ((row) * 256 + ((colB) ^ (((row) & 7) << 4)))
#define SBAR() __builtin_amdgcn_sched_barrier(0)
#define ABAR() asm volatile("s_waitcnt lgkmcnt(0)\n\ts_barrier" ::: "memory")
__device__ __forceinline__ int v_st(int k, int c) { const int kk = (k & ~0xC) | ((k & 4) << 1) | ((k & 8) >> 1); return ((kk >> 3) * 4 + (c >> 5)) * 512 + ((kk & 7) * 32 + (c & 31)) * 2; }
__device__ __forceinline__ int v_rd_base(int lane) { return ((lane & 3) << 3) | (((lane >> 2) & 3) << 6) | (((lane >> 4) & 1) << 5) | (((lane >> 5) & 1) << 8); }
constexpr int v_rd_off(int d0, int ks, int half) { return d0 * 512 + ks * 4096 + half * 2048; }
__device__ __forceinline__ int crow(int r, int hi) { return (r & 3) + 8 * (r >> 2) + 4 * hi; }
__device__ __forceinline__ unsigned cvtpk(float lo, float hi) { unsigned r; asm volatile("v_cvt_pk_bf16_f32 %0, %1, %2" : "=v"(r) : "v"(lo), "v"(hi)); return r; }
__device__ __forceinline__ bf16x8 load8(const bf16* p) { return *reinterpret_cast<const bf16x8*>(p); }
__device__ __forceinline__ void mask_causal(f32x16& p0, f32x16& p1, int dq) {
    const float NEG = -__builtin_inff();
#pragma unroll
    for (int r = 0; r < 16; ++r) { const int c = (r & 3) + 8 * (r >> 2); if (dq - c < 0) p0[r] = NEG; if (dq - c - 32 < 0) p1[r] = NEG; }
}
__device__ __forceinline__ void partialSM(f32x16& p0, f32x16& p1, float& m_reg, float& mn, float& alpha) {
    float pmax = p0[0];
#pragma unroll
    for (int r = 1; r < 16; ++r) pmax = fmaxf(pmax, p0[r]);
#pragma unroll
    for (int r = 0; r < 16; ++r) pmax = fmaxf(pmax, p1[r]);
    { auto rr = __builtin_amdgcn_permlane32_swap(__float_as_uint(pmax), __float_as_uint(pmax), false, false);
      pmax = fmaxf(__uint_as_float(rr[0]), __uint_as_float(rr[1])); }
    constexpr float C2 = 1.4426950408889634f * SCALE;
    if (__builtin_expect(__all((pmax - m_reg) * SCALE <= THR), 1)) { mn = m_reg; alpha = 1.f; }
    else { mn = fmaxf(m_reg, pmax); alpha = __builtin_amdgcn_exp2f((m_reg - mn) * C2); m_reg = mn; }
    const float mnL = -mn * C2;
#pragma unroll
    for (int r = 0; r < 16; ++r) p0[r] = fmaf(p0[r], C2, mnL);
#pragma unroll
    for (int r = 0; r < 16; ++r) p1[r] = fmaf(p1[r], C2, mnL);
#pragma unroll
    for (int r = 0; r < 16; ++r) p0[r] = __builtin_amdgcn_exp2f(p0[r]);
}
__device__ __forceinline__ void finishSM(f32x16& p0, f32x16& p1, float alpha, float& l_reg, bf16x8& pa0, bf16x8& pa1, bf16x8& pa2, bf16x8& pa3) {
#pragma unroll
    for (int r = 0; r < 16; ++r) p1[r] = __builtin_amdgcn_exp2f(p1[r]);
    float ps = 0;
#pragma unroll
    for (int r = 0; r < 16; ++r) ps += p0[r];
#pragma unroll
    for (int r = 0; r < 16; ++r) ps += p1[r];
    { auto rr = __builtin_amdgcn_permlane32_swap(__float_as_uint(ps), __float_as_uint(ps), false, false);
      ps = __uint_as_float(rr[0]) + __uint_as_float(rr[1]); }
    l_reg = l_reg * alpha + ps;
#define PK4(P, B_, OUT) do { unsigned a0 = cvtpk(P[B_+0], P[B_+1]), a1 = cvtpk(P[B_+2], P[B_+3]);                          \
        unsigned b0 = cvtpk(P[B_+4], P[B_+5]), b1 = cvtpk(P[B_+6], P[B_+7]);                                             \
        auto r0 = __builtin_amdgcn_permlane32_swap(a0, b0, false, false); auto r1 = __builtin_amdgcn_permlane32_swap(a1, b1, false, false); \
        u32x4 w = {r0[0], r1[0], r0[1], r1[1]}; OUT = *reinterpret_cast<bf16x8*>(&w); } while (0)
    PK4(p0, 0, pa0); PK4(p0, 8, pa1); PK4(p1, 0, pa2); PK4(p1, 8, pa3);
#undef PK4
}
template <int KB, int MODE>
__device__ __forceinline__ void qkt(f32x16& p0, f32x16& p1, const char* K_lds, int r32, int hi, const bf16x8* qr, float base, float slopeS, unsigned w0, unsigned w1) {
    const float NEG = -__builtin_inff();
#pragma unroll
    for (int r = 0; r < 16; ++r) { const int c = (r & 3) + 8 * (r >> 2);
        float b0 = fmaf(slopeS, (float)c, base), b1 = fmaf(slopeS, (float)(c + 32), base);
        if (MODE == 2) { b0 = ((w0 >> c) & 1u) ? b0 : NEG; b1 = ((w1 >> c) & 1u) ? b1 : NEG; }
        p0[r] = b0; p1[r] = b1; }
    const char* kb[4];
#pragma unroll
    for (int dd = 0; dd < 4; ++dd) kb[dd] = K_lds + KB * SHM_K + KSWZ(r32, (dd * 16 + hi * 8) * 2);
#pragma unroll
    for (int d0 = 0; d0 < 8; ++d0) { const char* a = kb[d0 & 3] + (d0 >> 2) * 128;
        bf16x8 b0 = *reinterpret_cast<const bf16x8*>(a);
        bf16x8 b1 = *reinterpret_cast<const bf16x8*>(a + 32 * 256);
        p0 = __builtin_amdgcn_mfma_f32_32x32x16_bf16(b0, qr[d0], p0, 0, 0, 0);
        p1 = __builtin_amdgcn_mfma_f32_32x32x16_bf16(b1, qr[d0], p1, 0, 0, 0); }
}
template <int VB>
__device__ __forceinline__ void pv_tile(f32x16* o, int vb0, bf16x8 pa0, bf16x8 pa1, bf16x8 pa2, bf16x8 pa3) {
#define TRRD(dst, off) asm volatile("ds_read_b64_tr_b16 %0, %1 offset:%2" : "=&v"(dst) : "v"(vb0), "i"(off) : "memory")
#define PV_D0(d0) do { s16x4 l0, l1, l2, l3, h0, h1, h2, h3; constexpr int b_ = VB * SHM_V + v_rd_off(d0, 0, 0); \
        TRRD(l0, b_); TRRD(h0, b_ + 2048); TRRD(l1, b_ + 4096); TRRD(h1, b_ + 6144); TRRD(l2, b_ + 8192); TRRD(h2, b_ + 10240); TRRD(l3, b_ + 12288); TRRD(h3, b_ + 14336); \
        asm volatile("s_waitcnt lgkmcnt(0)" ::: "memory"); SBAR();   \
        o[d0] = __builtin_amdgcn_mfma_f32_32x32x16_bf16(pa0, (bf16x8){l0[0], l0[1], l0[2], l0[3], h0[0], h0[1], h0[2], h0[3]}, o[d0], 0, 0, 0);   \
        o[d0] = __builtin_amdgcn_mfma_f32_32x32x16_bf16(pa1, (bf16x8){l1[0], l1[1], l1[2], l1[3], h1[0], h1[1], h1[2], h1[3]}, o[d0], 0, 0, 0);   \
        o[d0] = __builtin_amdgcn_mfma_f32_32x32x16_bf16(pa2, (bf16x8){l2[0], l2[1], l2[2], l2[3], h2[0], h2[1], h2[2], h2[3]}, o[d0], 0, 0, 0);   \
        o[d0] = __builtin_amdgcn_mfma_f32_32x32x16_bf16(pa3, (bf16x8){l3[0], l3[1], l3[2], l3[3], h3[0], h3[1], h3[2], h3[3]}, o[d0], 0, 0, 0); } while (0)
    PV_D0(0); PV_D0(1); PV_D0(2); PV_D0(3);
#undef PV_D0
#undef TRRD
}
struct Blk { const bf16* Q; const bf16* K; const bf16* V; bf16* O; int P0; float slopeS; const unsigned char* rm; const unsigned* bits; };
struct Seam { bf16x8 qr[8]; bf16x8 st_v0, st_v1, st_k0, st_k1; };
#define ROW(p, k0, rr) ((p) + (size_t)((k0) + (rr)) * pitch + sc)
#define VMW() asm volatile("s_waitcnt vmcnt(0)" ::: "memory")
#define VMWN(n) asm volatile("s_waitcnt vmcnt(%0)" :: "i"(n) : "memory")
#define SLOAD_H(Kp, Vp, k0) do { S.st_v0 = load8(ROW(Vp, k0, sr)); S.st_v1 = load8(ROW(Vp, k0, 32 + sr));              \
                         S.st_k0 = load8(ROW(Kp, k0, sr)); S.st_k1 = load8(ROW(Kp, k0, 32 + sr)); } while (0)
#define SWRITE_HK(bf) do { *(bf16x8*)(K_lds + (bf) * SHM_K + kws) = S.st_k0; *(bf16x8*)(K_lds + (bf) * SHM_K + kws + 32 * 256) = S.st_k1; } while (0)
#define SWRITE_HV(bf) do { *(bf16x8*)(V_lds + (bf) * SHM_V + vst0) = S.st_v0; *(bf16x8*)(V_lds + (bf) * SHM_V + vst1) = S.st_v1; } while (0)
#define SWRITE_H(bf) do { SWRITE_HV(bf); SWRITE_HK(bf); } while (0)
__device__ __forceinline__ void attn_prime(const Blk& cur, int pitch, char* lds, Seam& S) {
    int tid = threadIdx.x; asm volatile("" : "+v"(tid));
    const int wid = __builtin_amdgcn_readfirstlane(tid >> 6), lane = tid & 63, r32 = lane & 31, hi = lane >> 5;
    const int sr = tid >> 4, sc = (tid & 15) * 8, kws = KSWZ(sr, sc * 2); char* K_lds = lds + 2 * SHM_V;
#pragma unroll
    for (int d0 = 0; d0 < 8; ++d0) S.qr[d0] = load8(cur.Q + (size_t)(wid * QBLK + r32) * pitch + d0 * 16 + hi * 8);
    SLOAD_H(cur.K, cur.V, 0); VMW(); SWRITE_HK(0);
    ABAR();
}
template <int MODE>
__device__ __forceinline__ void attn_block(const Blk& cur, const Blk& nxt, int pitch, int opitch, char* lds, Seam& S) {
    int tid = threadIdx.x; asm volatile("" : "+v"(tid));
    const int wid = __builtin_amdgcn_readfirstlane(tid >> 6), lane = tid & 63, r32 = lane & 31, hi = lane >> 5;
    const int NT = (cur.P0 + QB) / KVBLK;
    const int qlo = cur.P0 + wid * QBLK, qm = qlo + r32 - 4 * hi;
    char* V_lds = lds; char* K_lds = lds + 2 * SHM_V;
    float* ws = (float*)(lds + 2 * SHM_V + 2 * SHM_K) + wid * 64; float* li_l = ws, * al_l = ws + 32;
    float m_reg = -1e30f, l_reg = 0; f32x16 o[4] = {};
    const int sr = tid >> 4, sc = (tid & 15) * 8, vst0 = v_st(sr, sc), vst1 = v_st(32 + sr, sc), kws = KSWZ(sr, sc * 2);
    const int vb0 = (int)(uintptr_t)V_lds + v_rd_base(lane);
    const bf16* Kh = cur.K; const bf16* Vh = cur.V;
    const float slopeS = cur.slopeS; const float NEGINF = -__builtin_inff();
    unsigned rmv = 0; if (MODE == 1) rmv = cur.rm[(size_t)(wid * QBLK + r32) * 16];
    const unsigned* bp = cur.bits + (size_t)(wid * QBLK + r32) * 64; u32x2 bw = {0u, 0u};
    if (MODE == 2) bw = *(const u32x2*)bp;
#define RESC(a) do { if (__any((a) < 1.f)) { if (hi == 0) al_l[r32] = (a); asm volatile("s_waitcnt lgkmcnt(0)" ::: "memory");              \
                     _Pragma("unroll") for (int d_ = 0; d_ < 4; ++d_) _Pragma("unroll") for (int r = 0; r < 16; ++r) o[d_][r] *= al_l[crow(r, hi)]; } } while (0)
#define KBASE(t) ((t) * KVBLK)
#define MASKT(P0_, P1_, t) do { if (MODE != 2) { const int kb_ = KBASE(t); if (kb_ + KVBLK - 1 > qlo) mask_causal(P0_, P1_, qm - kb_); } } while (0)
#define QKT(KB, PX0, PX1, t) do { const int kb_ = KBASE(t); float base_ = -slopeS * (float)(qm - kb_);                                     \
        if (MODE == 1) { if (!((rmv >> (kb_ >> 8)) & 1u)) base_ = NEGINF; }                                                                 \
        qkt<KB, MODE>(PX0, PX1, K_lds, r32, hi, S.qr, base_, slopeS, bw[0] >> (4 * hi), bw[1] >> (4 * hi));                                 \
        if (MODE == 2) { if ((t) + 1 < NT) bw = *(const u32x2*)(bp + 2 * ((t) + 1)); } } while (0)
#define SEAM_K0() do { VMWN(8); SWRITE_HK(0); SBAR(); } while (0)
    f32x16 pA0, pA1, pB0, pB1; float mnA, mnB, alA, alB; bf16x8 pa0, pa1, pa2, pa3;
    SWRITE_HV(0); SBAR();
    SLOAD_H(Kh, Vh, KBASE(1));
    SBAR(); QKT(0, pA0, pA1, 0);
    MASKT(pA0, pA1, 0); partialSM(pA0, pA1, m_reg, mnA, alA);
    VMW(); SWRITE_H(1);
    ABAR();
#define HALF_STEP(PX0, PX1, mnX, alX, PY0, PY1, alY, t, KB, VB, SB) do {                                                      \
        SBAR(); QKT(KB, PX0, PX1, t);                                                                                         \
        finishSM(PY0, PY1, alY, l_reg, pa0, pa1, pa2, pa3); SBAR();                                                           \
        if ((t) + 1 < NT) { SLOAD_H(Kh, Vh, KBASE((t) + 1)); SBAR(); }                                                        \
        pv_tile<VB>(o, vb0, pa0, pa1, pa2, pa3); MASKT(PX0, PX1, (t)); partialSM(PX0, PX1, m_reg, mnX, alX);                  \
        ABAR();                                                                                                               \
        if ((t) + 1 < NT) { VMW(); SWRITE_H(SB); }                                                                            \
        RESC(alX); ABAR(); } while (0)
    for (int t = 1; t + 1 < NT; t += 2) {
        HALF_STEP(pB0, pB1, mnB, alB, pA0, pA1, alA, t, 1, 0, 0);
        HALF_STEP(pA0, pA1, mnA, alA, pB0, pB1, alB, t + 1, 0, 1, 1);
    }
    SBAR(); QKT(1, pB0, pB1, NT - 1); SBAR();
    SLOAD_H(nxt.K, nxt.V, 0); SBAR();
#pragma unroll
    for (int d0 = 0; d0 < 8; ++d0) S.qr[d0] = load8(nxt.Q + (size_t)(wid * QBLK + r32) * pitch + d0 * 16 + hi * 8);
    SBAR();
    finishSM(pA0, pA1, alA, l_reg, pa0, pa1, pa2, pa3); SBAR();
    pv_tile<0>(o, vb0, pa0, pa1, pa2, pa3);
    MASKT(pB0, pB1, NT - 1); partialSM(pB0, pB1, m_reg, mnB, alB); ABAR(); RESC(alB);
    finishSM(pB0, pB1, alB, l_reg, pa0, pa1, pa2, pa3); SBAR(); pv_tile<1>(o, vb0, pa0, pa1, pa2, pa3);
    SBAR(); SEAM_K0();
    if (hi == 0) li_l[r32] = l_reg; asm volatile("s_waitcnt lgkmcnt(0)" ::: "memory");
    float rli[16];
#pragma unroll
    for (int r = 0; r < 16; ++r) rli[r] = __builtin_amdgcn_rcpf(li_l[crow(r, hi)]);
    bf16* Ow = cur.O + (size_t)(wid * QBLK) * opitch;
#pragma unroll
    for (int r = 0; r < 16; ++r) { const int orow = crow(r, hi);
#pragma unroll
        for (int d0 = 0; d0 < 4; ++d0) { const float v = o[d0][r] * rli[r];
            const float vn = __int_as_float(__builtin_amdgcn_update_dpp(0, __float_as_int(v), 0xB1, 0xf, 0xf, true));
            if ((r32 & 1) == 0) *(unsigned*)(Ow + (size_t)orow * opitch + d0 * 32 + r32) = cvtpk(v, vn); } }
    ABAR();
#undef RESC
#undef KBASE
#undef MASKT
#undef QKT
#undef SEAM_K0
#undef HALF_STEP
}
#undef ROW
#undef SLOAD_H
#undef SWRITE_HK
#undef SWRITE_HV
#undef SWRITE_H
template <int MODE>
__device__ __forceinline__ Blk make_blk(int L, int pass, int total, const bf16* QKV, int pitch, bf16* Obuf, int opitch, const unsigned char* rowmask, const unsigned* selbits) {
    const int v = (L & 7) * (total >> 3) + (L >> 3);
    const int bh = v >> 2, x = v & 3, qb = pass ? 7 - x : x;
    const int nh = total >> 4, b = bh / nh, hh = bh - b * nh;
    const size_t row0 = (size_t)b * 2048 + (size_t)qb * QB;
    int qcol, kcol, vcol, ocol; float slope;
    if (MODE == 0) { const int h = hh >> 2, m = (hh >> 1) & 1, vf = hh & 1; qcol = h * 256 + m * 128; kcol = 2048 + qcol; vcol = 4096 + h * 256 + vf * 128; ocol = (h * 2 + m) * 256 + vf * 128; slope = __builtin_amdgcn_exp2f(-(float)(h + 1)); }
    else if (MODE == 1) { qcol = hh * 128; kcol = 2048 + qcol; vcol = 4096 + qcol; ocol = qcol; slope = __builtin_amdgcn_exp2f(-0.5f * (float)(hh + 1)); }
    else { const int g = hh >> 2; qcol = hh * 128; kcol = 2048 + g * 128; vcol = 2560 + g * 128; ocol = qcol; slope = __builtin_amdgcn_exp2f(-0.5f * (float)(hh + 1)); }
    Blk r;
    r.Q = QKV + row0 * pitch + qcol; r.K = QKV + (size_t)b * 2048 * pitch + kcol; r.V = QKV + (size_t)b * 2048 * pitch + vcol;
    r.O = Obuf + row0 * opitch + ocol; r.P0 = qb * QB; r.slopeS = slope * (1.0f / SCALE);
    r.rm = rowmask + row0 * 16 + hh; r.bits = selbits + row0 * 64;
    return r;
}
template <int MODE>
__device__ __forceinline__ void attn_phase(char* lds, const bf16* QKV, int pitch, bf16* Obuf, int opitch, const unsigned char* rowmask, const unsigned* selbits, int nheads, int blk, int G) {
    const int total = 16 * nheads;
    int L = blk; if (L >= total) return;
    int pass = 0;
    Blk cur = make_blk<MODE>(L, 0, total, QKV, pitch, Obuf, opitch, rowmask, selbits);
    Seam S;
    attn_prime(cur, pitch, lds, S);
    for (;;) {
        const bool more_pass = pass == 0, more_item = L + G < total, last = !more_pass && !more_item;
        int passn = pass + 1, Ln = L;
        if (!more_pass) { passn = 0; Ln = more_item ? L + G : L; }
        const Blk nxt = last ? cur : make_blk<MODE>(Ln, passn, total, QKV, pitch, Obuf, opitch, rowmask, selbits);
        attn_block<MODE>(cur, nxt, pitch, opitch, lds, S);
        if (last) break;
        cur = nxt; pass = passn; L = Ln;
    }
}
#undef SBAR
#undef ABAR
#undef VMW
#undef VMWN
#undef KSWZ
}
#ifndef PG8_SP2
#define PG8_SP2 true
#endif
#ifndef PG8_ALIGN
#define PG8_ALIGN true
#endif
#ifndef MK_PER_PHASE
#define MK_PER_PHASE 0
#endif
constexpr int NWAVES = 8;
constexpr int T_TOK = 8192, SEQ = 2048, DM = 2048, FF = 5632, PLE = 256, DEPTH = 4;
constexpr int NA_IN = 6144, NC_IN_PAD = 4352, NC_IN = 4176;
constexpr float LN_EPS = 1e-5f, RMS_EPS = 1e-6f;
constexpr float ALPHA = 1.681792830507429f;
constexpr size_t MiB = 1u << 20;
constexpr size_t WS_CTL = 0, CTL_ZERO_BYTES = 1 * MiB;
constexpr size_t WS_W = 1 * MiB;
constexpr size_t LW_F1IN = 0, LW_F1OUT = 44 * MiB, LW_F2IN = 66 * MiB, LW_F2OUT = 110 * MiB, LW_PG = 132 * MiB, LW_PP = 140 * MiB, LW_BYTES = 141 * MiB;
constexpr size_t WS_MIX = WS_W + 4 * LW_BYTES;
constexpr size_t MW_A_IN = 0, MW_A_OUT = 24 * MiB, MW_A_STRIDE = 32 * MiB, MW_B_IN = 64 * MiB, MW_B_OUT = 88 * MiB, MW_C_IN = 96 * MiB, MW_C_OUT = 113 * MiB, MW_BYTES = 121 * MiB;
constexpr size_t WS_X = WS_MIX + MW_BYTES;
constexpr size_t WS_Z = WS_X + 64 * MiB;
constexpr size_t WS_XB = WS_Z + 64 * MiB;
constexpr size_t WS_H = WS_XB + 32 * MiB;
constexpr size_t WS_QKV = WS_H + 88 * MiB;
constexpr size_t WS_AO = WS_QKV + 96 * MiB;
constexpr size_t WS_OP = WS_AO + 32 * MiB;
constexpr size_t WS_PP = WS_OP + 64 * MiB;
constexpr size_t WS_PB = WS_PP + 64 * MiB;
constexpr size_t WS_SEL = WS_PB + 16 * MiB;
constexpr size_t WS_RM = WS_SEL + 2 * MiB;
constexpr size_t WS_END = WS_RM + 1 * MiB;
constexpr int CW_TMO = 0, CW_CODE = 1, CW_BAR = 4096;
constexpr int RING_OFF = 0, RING_BYTES = 131072;
constexpr int LDSCTL_OFF = RING_BYTES, MISC_OFF = LDSCTL_OFF + 320;
constexpr int LDS_BYTES = 147456;
static_assert(MISC_OFF + 128 <= LDS_BYTES && att::LDS_BYTES <= RING_BYTES, "LDS map");
#define GAS __attribute__((address_space(1)))
#define LAS __attribute__((address_space(3)))
typedef unsigned short bf16;
typedef unsigned v4u __attribute__((ext_vector_type(4)));
typedef float f32x4 __attribute__((ext_vector_type(4)));
typedef short bf16x8 __attribute__((ext_vector_type(8)));
typedef GAS unsigned gu32;
typedef GAS unsigned long long gu64;
#define RLX_AGENT __ATOMIC_RELAXED, __HIP_MEMORY_SCOPE_AGENT
#define LDS_WAIT() asm volatile("s_waitcnt lgkmcnt(0)" ::: "memory")
#define VM_WAIT() asm volatile("s_waitcnt vmcnt(0)" ::: "memory")
__device__ __forceinline__ unsigned long long rt() { return __builtin_amdgcn_s_memrealtime(); }
__device__ __forceinline__ unsigned f2bf(float f) { unsigned u = __builtin_bit_cast(unsigned, f); return (u + 0x7fffu + ((u >> 16) & 1u)) >> 16; }
__device__ __forceinline__ unsigned pk2(float lo, float hi) { return f2bf(lo) | (f2bf(hi) << 16); }
#define XB_TMO      128
#define XB_XCNT(j)  (256  + 64 * (j))
#define XB_XSUB(j)  (1280 + 64 * (j))
#define XB_XGEN(j)  (2304 + 64 * (j))
#define XB_TOP      3328
#define XB_TOPGEN   3392
#define XCD_BAR_WORDS 3456
#define XB_SPIN_CAP (1u << 18)

__device__ __forceinline__ unsigned xb_ld(unsigned* p)              { return __hip_atomic_load((GAS unsigned*)p, __ATOMIC_RELAXED, __HIP_MEMORY_SCOPE_AGENT); }
__device__ __forceinline__ unsigned xb_add(unsigned* p, unsigned v) { return __hip_atomic_fetch_add((GAS unsigned*)p, v, __ATOMIC_RELAXED, __HIP_MEMORY_SCOPE_AGENT); }
__device__ __forceinline__ unsigned xb_xcc_id() { return (unsigned)__builtin_amdgcn_s_getreg((3 << 11) | 20) & 0xFu; }
#define XB_SPIN(cond, bar) do { unsigned _sp = 0; while (cond) { __builtin_amdgcn_s_sleep(1); \
    if ((++_sp & 255u) == 0u) { if (xb_ld(&(bar)[XB_TMO])) break; if (_sp > XB_SPIN_CAP) { (void)xb_add(&(bar)[XB_TMO], 1u); break; } } } } while (0)

struct XcdBarrier {
    unsigned* bar; unsigned x;
    volatile LAS unsigned* st;
};

__device__ __forceinline__ XcdBarrier xcd_barrier_post(unsigned* bar, volatile LAS unsigned* st) {
    XcdBarrier b; b.bar = bar; b.x = xb_xcc_id(); b.st = st;
    if (threadIdx.x == 0) (void)xb_add(&bar[XB_XCNT(b.x)], 1u);
    return b;
}
__device__ __forceinline__ void xcd_barrier_complete(unsigned* bar, unsigned x, unsigned& nloc, unsigned& nx) {
    const unsigned G = gridDim.x * gridDim.y * gridDim.z;
    unsigned sum, cnt, mine, sp = 0u;
    for (;;) {
        sum = 0u; cnt = 0u; mine = 0u;
#pragma unroll
        for (unsigned j = 0; j < 16; ++j) { const unsigned c = xb_ld(&bar[XB_XCNT(j)]); sum += c; cnt += (c > 0u) ? 1u : 0u; mine = (j == x) ? c : mine; }
        if (sum == G) break;
        __builtin_amdgcn_s_sleep(1);
        if ((++sp & 255u) == 0u) { if (xb_ld(&bar[XB_TMO])) break; if (sp > XB_SPIN_CAP) { (void)xb_add(&bar[XB_TMO], 1u); break; } }
    }
    nloc = mine > 0u ? mine : 1u; nx = cnt > 0u ? cnt : 1u;
}

__device__ __forceinline__ void xcd_barrier(const XcdBarrier& b) {
    asm volatile("s_waitcnt vmcnt(0)" ::: "memory");
    __syncthreads();
    if (threadIdx.x == 0) {
        unsigned* bar = b.bar;
        __builtin_amdgcn_s_waitcnt(0);
        unsigned nloc = b.st[0], nx = b.st[1];
        if (nloc == 0u) { xcd_barrier_complete(bar, b.x, nloc, nx); b.st[0] = nloc; b.st[1] = nx; }
        const unsigned old = xb_add(&bar[XB_XSUB(b.x)], 1u);
        const unsigned gen = old / nloc;
        if (old + 1u == (gen + 1u) * nloc) {
            __builtin_amdgcn_fence(__ATOMIC_RELEASE, "agent");
            asm volatile("s_waitcnt vmcnt(0)" ::: "memory");
            const unsigned og = xb_add(&bar[XB_TOP], 1u);
            const unsigned tg = og / nx;
            if (og + 1u == (tg + 1u) * nx) xb_add(&bar[XB_TOPGEN], 1u);
            else XB_SPIN(xb_ld(&bar[XB_TOPGEN]) == tg, bar);
            __builtin_amdgcn_fence(__ATOMIC_ACQUIRE, "agent");
            xb_add(&bar[XB_XGEN(b.x)], 1u);
            asm volatile("s_waitcnt vmcnt(0)" ::: "memory");
        } else {
            XB_SPIN(xb_ld(&bar[XB_XGEN(b.x)]) == gen, bar);
            __builtin_amdgcn_fence(__ATOMIC_ACQUIRE, "agent");
            asm volatile("s_waitcnt vmcnt(0)" ::: "memory");
        }
    }
    __syncthreads();
}
typedef unsigned u32x2 __attribute__((ext_vector_type(2)));
typedef float f32x16 __attribute__((ext_vector_type(16)));
__device__ __forceinline__ unsigned cvtpk2(float lo, float hi) { unsigned r; asm volatile("v_cvt_pk_bf16_f32 %0, %1, %2" : "=v"(r) : "v"(lo), "v"(hi)); return r; }
__device__ __forceinline__ float bf2f(unsigned short h) { return __uint_as_float((unsigned)h << 16); }
template <int M> __device__ __forceinline__ int swz_xor_i(int v) {
    if (M == 1) return __builtin_amdgcn_update_dpp(v, v, 0xB1, 0xf, 0xf, true);
    else if (M == 2) return __builtin_amdgcn_update_dpp(v, v, 0x4E, 0xf, 0xf, true);
    else return __builtin_amdgcn_ds_swizzle(v, (M << 10) | 0x1f);
}
template <int M> __device__ __forceinline__ float swz_xor(float v) { return __int_as_float(swz_xor_i<M>(__float_as_int(v))); }
__device__ __forceinline__ float wave_sum(float v) {
    v += swz_xor<1>(v); v += swz_xor<2>(v); v += swz_xor<4>(v); v += swz_xor<8>(v); v += swz_xor<16>(v);
    auto rr = __builtin_amdgcn_permlane32_swap(__float_as_uint(v), __float_as_uint(v), false, false);
    return __uint_as_float(rr[0]) + __uint_as_float(rr[1]);
}
struct WDesc { const float* src; bf16* dst; int K, N, Npad, mode; };
__device__ __forceinline__ void transpose_item(const WDesc& d, LAS float* scr, int item, int lane) {
    const int nblk = d.Npad / 32, kb = item / nblk, nb = item - kb * nblk, k0 = 64 * kb, n0 = 32 * nb;
    const int nn = n0 + (lane & 31); const bool ok = nn < d.N;
#pragma unroll 8
    for (int i = 0; i < 32; ++i) { const int kk = 2 * i + (lane >> 5); scr[kk * 33 + (lane & 31)] = ok ? d.src[(size_t)(k0 + kk) * d.N + nn] : 0.f; }
    LDS_WAIT(); asm volatile("" ::: "memory");
    int drow0 = n0;
    if (d.mode == 1) { const int bj = n0 >= FF ? 1 : 0, cc = n0 - bj * FF; drow0 = 256 * (cc >> 7) + 128 * bj + (cc & 127); }
    const int c = lane & 7;
#pragma unroll
    for (int j = 0; j < 4; ++j) { const int n = (lane >> 3) + 8 * j; const LAS float* s = scr + (8 * c) * 33 + n;
        v4u o; o.x = cvtpk2(s[0 * 33], s[1 * 33]); o.y = cvtpk2(s[2 * 33], s[3 * 33]); o.z = cvtpk2(s[4 * 33], s[5 * 33]); o.w = cvtpk2(s[6 * 33], s[7 * 33]);
        *(GAS v4u*)(d.dst + (size_t)(drow0 + n) * d.K + k0 + 8 * c) = o; }
    LDS_WAIT(); asm volatile("" ::: "memory");
}
struct Args { const float* in[21]; float* out; unsigned char* ws; int ph_lo, ph_hi; };
__device__ __forceinline__ const void* karg_ptr(unsigned off);
__device__ __forceinline__ WDesc wdesc(unsigned char* ws, int mi) {
    WDesc d; d.mode = 0;
    if (mi < 24) { const int l = mi / 6, k = mi - 6 * l; unsigned char* lb = ws + WS_W + (size_t)l * LW_BYTES;
        if (k == 0)      { d.src = ((const float*)karg_ptr(8u * 2)) + (size_t)l * DM * 2 * FF; d.dst = (bf16*)(lb + LW_F1IN);  d.K = DM;  d.N = 2 * FF; d.mode = 1; }
        else if (k == 1) { d.src = ((const float*)karg_ptr(8u * 3)) + (size_t)l * FF * DM;     d.dst = (bf16*)(lb + LW_F1OUT); d.K = FF;  d.N = DM; }
        else if (k == 2) { d.src = ((const float*)karg_ptr(8u * 4)) + (size_t)l * DM * 2 * FF; d.dst = (bf16*)(lb + LW_F2IN);  d.K = DM;  d.N = 2 * FF; d.mode = 1; }
        else if (k == 3) { d.src = ((const float*)karg_ptr(8u * 5)) + (size_t)l * FF * DM;     d.dst = (bf16*)(lb + LW_F2OUT); d.K = FF;  d.N = DM; }
        else if (k == 4) { d.src = ((const float*)karg_ptr(8u * 8)) + (size_t)l * DM * DM;     d.dst = (bf16*)(lb + LW_PG);    d.K = DM;  d.N = DM; }
        else             { d.src = ((const float*)karg_ptr(8u * 9)) + (size_t)l * PLE * DM;    d.dst = (bf16*)(lb + LW_PP);    d.K = PLE; d.N = DM; }
        d.Npad = d.N; return d; }
    unsigned char* mb = ws + WS_MIX; const int k = mi - 24;
    if (k == 0)      { d.src = ((const float*)karg_ptr(8u * 10));                         d.dst = (bf16*)(mb + MW_A_IN);                d.K = DM; d.N = NA_IN; }
    else if (k == 1) { d.src = ((const float*)karg_ptr(8u * 11));                         d.dst = (bf16*)(mb + MW_A_OUT);               d.K = DM; d.N = DM; }
    else if (k == 2) { d.src = ((const float*)karg_ptr(8u * 10)) + (size_t)DM * NA_IN;    d.dst = (bf16*)(mb + MW_A_STRIDE + MW_A_IN);  d.K = DM; d.N = NA_IN; }
    else if (k == 3) { d.src = ((const float*)karg_ptr(8u * 11)) + (size_t)DM * DM;       d.dst = (bf16*)(mb + MW_A_STRIDE + MW_A_OUT); d.K = DM; d.N = DM; }
    else if (k == 4) { d.src = ((const float*)karg_ptr(8u * 17));                         d.dst = (bf16*)(mb + MW_B_IN);                d.K = DM; d.N = NA_IN; }
    else if (k == 5) { d.src = ((const float*)karg_ptr(8u * 18));                         d.dst = (bf16*)(mb + MW_B_OUT);               d.K = DM; d.N = DM; }
    else if (k == 6) { d.src = ((const float*)karg_ptr(8u * 19));                         d.dst = (bf16*)(mb + MW_C_IN);                d.K = DM; d.N = NC_IN; d.Npad = NC_IN_PAD; return d; }
    else             { d.src = ((const float*)karg_ptr(8u * 20));                         d.dst = (bf16*)(mb + MW_C_OUT);               d.K = DM; d.N = DM; }
    d.Npad = d.N; return d;
}
constexpr int N_WMATS = 32;
__device__ __forceinline__ void cvt_rows(const float* src, bf16* dst, size_t n, int gt, int ngt) {
    for (size_t i = (size_t)gt * 8; i < n; i += (size_t)ngt * 8) { const f32x4 a = *(const GAS f32x4*)(src + i), b = *(const GAS f32x4*)(src + i + 4);
        v4u o; o.x = cvtpk2(a.x, a.y); o.y = cvtpk2(a.z, a.w); o.z = cvtpk2(b.x, b.y); o.w = cvtpk2(b.z, b.w); *(GAS v4u*)(dst + i) = o; }
}
__device__ __forceinline__ void ln_phase(const float* Z, const float* g, const float* b, float* X, bf16* XB, int gw, int ngw, int lane) {
    f32x4 gv[8], bv[8];
#pragma unroll
    for (int j = 0; j < 8; ++j) { gv[j] = *((const GAS f32x4*)g + lane + 64 * j); bv[j] = *((const GAS f32x4*)b + lane + 64 * j); }
    for (int row = gw; row < T_TOK; row += ngw) {
        const GAS f32x4* zr = (const GAS f32x4*)(Z + (size_t)row * DM) + lane;
        f32x4 v[8]; float s = 0.f;
#pragma unroll
        for (int j = 0; j < 8; ++j) { v[j] = zr[64 * j]; s += (v[j].x + v[j].y) + (v[j].z + v[j].w); }
        const float mean = wave_sum(s) * (1.f / DM); float s2 = 0.f;
#pragma unroll
        for (int j = 0; j < 8; ++j) { v[j] = v[j] - mean; s2 += (v[j].x * v[j].x + v[j].y * v[j].y) + (v[j].z * v[j].z + v[j].w * v[j].w); }
        const float rstd = 1.f / sqrtf(wave_sum(s2) * (1.f / DM) + LN_EPS);
        GAS f32x4* xo = (GAS f32x4*)(X + (size_t)row * DM) + lane;
#pragma unroll
        for (int j = 0; j < 8; ++j) { v[j] = v[j] * rstd * gv[j] + bv[j]; xo[64 * j] = v[j]; }
        if (XB) { GAS u32x2* o8 = (GAS u32x2*)(XB + (size_t)row * DM) + lane;
#pragma unroll
            for (int j = 0; j < 8; ++j) { u32x2 w; w.x = cvtpk2(v[j].x, v[j].y); w.y = cvtpk2(v[j].z, v[j].w); o8[64 * j] = w; } }
    }
}
__device__ __forceinline__ void diff_combine_phase(const bf16* OP, bf16* AO, const float* lq1, const float* lk1, const float* lq2, const float* lk2, const float* sg, float lambda_init, int gw, int ngw, int lane) {
    const float s1 = wave_sum(lq1[lane] * lk1[lane] + lq1[lane + 64] * lk1[lane + 64]);
    const float s2 = wave_sum(lq2[lane] * lk2[lane] + lq2[lane + 64] * lk2[lane + 64]);
    const float lam = expf(s1) - expf(s2) + lambda_init;
    const f32x4 gg = *((const GAS f32x4*)sg + lane); const float post = 1.0f - lambda_init;
    for (int row = gw; row < T_TOK; row += ngw) {
        const GAS u32x2* src = (const GAS u32x2*)(OP + (size_t)row * 4096) + lane;
        u32x2 a[8], b[8];
#pragma unroll
        for (int h = 0; h < 8; ++h) { a[h] = src[h * 128]; b[h] = src[h * 128 + 64]; }
#pragma unroll
        for (int h = 0; h < 8; ++h) {
            float d0 = __uint_as_float(a[h].x << 16) - lam * __uint_as_float(b[h].x << 16), d1 = __uint_as_float(a[h].x & 0xffff0000u) - lam * __uint_as_float(b[h].x & 0xffff0000u);
            float d2 = __uint_as_float(a[h].y << 16) - lam * __uint_as_float(b[h].y << 16), d3 = __uint_as_float(a[h].y & 0xffff0000u) - lam * __uint_as_float(b[h].y & 0xffff0000u);
            const float ss = wave_sum((d0 * d0 + d1 * d1) + (d2 * d2 + d3 * d3));
            const float r = post / sqrtf(ss * (1.f / 256.f) + RMS_EPS);
            u32x2 w; w.x = cvtpk2(d0 * r * gg.x, d1 * r * gg.y); w.y = cvtpk2(d2 * r * gg.z, d3 * r * gg.w);
            *((GAS u32x2*)(AO + (size_t)row * DM + h * 256) + lane) = w; }
    }
}
__device__ __forceinline__ void moba_gate_phase(const bf16* QKV, unsigned char* rowmask, LAS unsigned char* ldsb, int vcu, int G, int tid) {
    LAS float* part = (LAS float*)ldsb;
    LAS float* kmean = (LAS float*)(ldsb + 16384);
    for (int u = vcu; u < 512; u += G) {
        const int r = u >> 8, uu = u & 255, b = uu >> 6, h = (uu >> 2) & 15, x = uu & 3, own = r ? 7 - x : x;
        const bf16* Kb = QKV + (size_t)b * SEQ * NA_IN + 2048 + h * 128;
        const int rg = tid >> 4, cc = (tid & 15) * 8;
        for (int n = 0; n < own; ++n) {
            float s[8] = {0.f, 0.f, 0.f, 0.f, 0.f, 0.f, 0.f, 0.f};
#pragma unroll
            for (int i = 0; i < 8; ++i) { const v4u kv = *(const GAS v4u*)(Kb + (size_t)(n * 256 + rg + 32 * i) * NA_IN + cc);
                s[0] += __uint_as_float(kv.x << 16); s[1] += __uint_as_float(kv.x & 0xffff0000u); s[2] += __uint_as_float(kv.y << 16); s[3] += __uint_as_float(kv.y & 0xffff0000u);
                s[4] += __uint_as_float(kv.z << 16); s[5] += __uint_as_float(kv.z & 0xffff0000u); s[6] += __uint_as_float(kv.w << 16); s[7] += __uint_as_float(kv.w & 0xffff0000u); }
#pragma unroll
            for (int k = 0; k < 8; ++k) part[rg * 128 + cc + k] = s[k];
            __syncthreads();
            if (tid < 128) { float t = 0.f;
#pragma unroll 8
                for (int i = 0; i < 32; ++i) t += part[i * 128 + tid];
                kmean[n * 128 + tid] = t * (1.f / 256.f); }
            __syncthreads();
        }
        const int q = tid >> 1, half = tid & 1;
        const size_t qrow = (size_t)b * SEQ + own * 256 + q;
        const bf16* qp = QKV + qrow * NA_IN + h * 128 + half * 64;
        float qv[64];
#pragma unroll
        for (int i = 0; i < 8; ++i) { const v4u kv = *(const GAS v4u*)(qp + 8 * i);
            qv[8 * i + 0] = __uint_as_float(kv.x << 16); qv[8 * i + 1] = __uint_as_float(kv.x & 0xffff0000u); qv[8 * i + 2] = __uint_as_float(kv.y << 16); qv[8 * i + 3] = __uint_as_float(kv.y & 0xffff0000u);
            qv[8 * i + 4] = __uint_as_float(kv.z << 16); qv[8 * i + 5] = __uint_as_float(kv.z & 0xffff0000u); qv[8 * i + 6] = __uint_as_float(kv.w << 16); qv[8 * i + 7] = __uint_as_float(kv.w & 0xffff0000u); }
        float gt[7];
#pragma unroll
        for (int n = 0; n < 7; ++n) { float acc = 0.f;
            if (n < own) {
#pragma unroll
                for (int d4 = 0; d4 < 16; ++d4) { const f32x4 km = *(const LAS f32x4*)(kmean + n * 128 + half * 64 + 4 * d4);
                    acc = fmaf(qv[4 * d4 + 0], km.x, acc); acc = fmaf(qv[4 * d4 + 1], km.y, acc); acc = fmaf(qv[4 * d4 + 2], km.z, acc); acc = fmaf(qv[4 * d4 + 3], km.w, acc); } }
            acc += swz_xor<1>(acc); gt[n] = acc; }
        unsigned m = 0u;
#pragma unroll
        for (int k = 0; k < 3; ++k) { int best = -1; float bv = -__builtin_inff();
#pragma unroll
            for (int n = 0; n < 7; ++n) if (n < own && !((m >> n) & 1u) && gt[n] > bv) { bv = gt[n]; best = n; }
            if (best >= 0) m |= 1u << best; }
        m |= 1u << own;
        if (half == 0) rowmask[qrow * 16 + h] = (unsigned char)m;
        __syncthreads();
    }
}
__device__ __forceinline__ void dsa_index_phase(const bf16* QKV, unsigned* selbits, int gw, int ngw, int lane) {
    typedef short bf16x8 __attribute__((ext_vector_type(8)));
    const int c = lane & 31, hi = lane >> 5;
    for (int id = gw; id < 4096; id += ngw) {
        const int rnd = id / ngw, b = id >> 10, j0 = id & 1023, tp = (rnd & 1) ? 1023 - j0 : j0;
        const size_t row0 = (size_t)b * SEQ + 2 * tp;
        const int ntile = (2 * tp + 1) / 32 + 1, t_me = 2 * tp + hi;
        const int qq = (c >> 2) & 1, head = (c & 3) + 4 * (c >> 3);
        const bf16* ap = QKV + (row0 + qq) * NC_IN_PAD + 3072 + head * 64 + 8 * hi;
        bf16x8 a[4];
#pragma unroll
        for (int s = 0; s < 4; ++s) a[s] = *(const bf16x8*)(ap + 16 * s);
        float wf[16];
        { const bf16* wp = QKV + (row0 + hi) * NC_IN_PAD + 4160; const v4u w0 = *(const GAS v4u*)wp, w1 = *(const GAS v4u*)(wp + 8);
          const unsigned ww[8] = {w0.x, w0.y, w0.z, w0.w, w1.x, w1.y, w1.z, w1.w};
#pragma unroll
          for (int i = 0; i < 8; ++i) { wf[2 * i] = __uint_as_float(ww[i] << 16) * 0.03125f; wf[2 * i + 1] = __uint_as_float(ww[i] & 0xffff0000u) * 0.03125f; } }
        const bf16* kp = QKV + ((size_t)b * SEQ + c) * NC_IN_PAD + 4096 + 8 * hi;
        unsigned u[64];
#pragma unroll
        for (int j = 0; j < 64; ++j) {
            float sc = -__builtin_inff();
            if (j < ntile) {
                bf16x8 bb[4];
#pragma unroll
                for (int s = 0; s < 4; ++s) bb[s] = *(const bf16x8*)(kp + (size_t)j * 32 * NC_IN_PAD + 16 * s);
                f32x16 acc = {};
#pragma unroll
                for (int s = 0; s < 4; ++s) acc = __builtin_amdgcn_mfma_f32_32x32x16_bf16(a[s], bb[s], acc, 0, 0, 0);
                float v = 0.f;
#pragma unroll
                for (int r = 0; r < 16; ++r) v = fmaf(wf[r], fmaxf(acc[r], 0.f), v);
                if (32 * j + c <= t_me) sc = v;
            }
            const unsigned bits = __float_as_uint(sc);
            u[j] = bits ^ ((unsigned)((int)bits >> 31) | 0x80000000u);
        }
        unsigned T = 0u;
        for (int bit = 31; bit >= 0; --bit) {
            const unsigned cand = T | (1u << bit); int cnt = 0;
#pragma unroll
            for (int j = 0; j < 64; ++j) cnt += (u[j] >= cand) ? 1 : 0;
            cnt += swz_xor_i<1>(cnt); cnt += swz_xor_i<2>(cnt); cnt += swz_xor_i<4>(cnt); cnt += swz_xor_i<8>(cnt); cnt += swz_xor_i<16>(cnt);
            if (cnt >= 256) T = cand;
        }
        if (T < 0x00800000u) T = 0x00800000u;
        unsigned mylo = 0u, myhi = 0u;
#pragma unroll
        for (int j = 0; j < 64; ++j) { const unsigned long long bal = __ballot(u[j] >= T); if (lane == j) { mylo = (unsigned)bal; myhi = (unsigned)(bal >> 32); } }
        selbits[row0 * 64 + lane] = mylo; selbits[(row0 + 1) * 64 + lane] = myhi;
    }
}
constexpr int N_PHASES = 1 + 13 * DEPTH;
__device__ __forceinline__ const void* karg_ptr(unsigned off) {
    asm volatile("" : "+s"(off));
    const __attribute__((address_space(4))) char* ka = (const __attribute__((address_space(4))) char*)__builtin_amdgcn_kernarg_segment_ptr();
    return *(const void* const __attribute__((address_space(4)))*)(ka + off);
}
#define KIN(i) ((const float*)karg_ptr(8u * (i)))
#define KOUT() ((float*)karg_ptr(168u))
#define KWS() ((unsigned char*)karg_ptr(176u))
static_assert(offsetof(Args, out) == 168 && offsetof(Args, ws) == 176 && offsetof(Args, ph_lo) == 184 && offsetof(Args, ph_hi) == 188 && sizeof(Args) == 192, "Args layout");
#define TIDS() int tid = threadIdx.x; asm volatile("" : "+v"(tid)); const int lane = tid & 63, wave = __builtin_amdgcn_readfirstlane(tid >> 6), gw = vcu * NWAVES + wave, ngw = G * NWAVES; (void)lane; (void)gw; (void)ngw
__global__ void __launch_bounds__(NWAVES * 64, 2) mega_fwd(Args args) {
    extern __shared__ __attribute__((aligned(16))) unsigned char lds[];
    LAS unsigned char* const ldsl = (LAS unsigned char*)lds;
    const int G = gridDim.x, bx = blockIdx.x, vcu = (G % 8 == 0) ? (bx % 8) * (G / 8) + bx / 8 : bx;
    { volatile LAS unsigned* const MISC0 = (volatile LAS unsigned*)(ldsl + LDSCTL_OFF);
      for (int u = threadIdx.x; u < (LDS_BYTES - LDSCTL_OFF) / 4; u += NWAVES * 64) MISC0[u] = 0u; }
    __syncthreads();
    XcdBarrier bar = xcd_barrier_post((unsigned*)((gu32*)(KWS() + WS_CTL) + CW_BAR), (volatile LAS unsigned*)(ldsl + MISC_OFF) + 8);
    int pc = 0; const int lo = args.ph_lo, hi = args.ph_hi;
#define RUN (pc >= lo && pc < hi)
#define SEAM() do { if (pc >= lo && pc + 1 < hi) xcd_barrier(bar); ++pc; } while (0)

    if (RUN) {
        TIDS(); unsigned char* const ws = KWS();
        LAS float* scr = (LAS float*)(ldsl + RING_OFF + wave * 16384);
        for (int mi = 0; mi < N_WMATS; ++mi) { const WDesc d = wdesc(ws, mi); const int nitems = (d.K / 64) * (d.Npad / 32);
            for (int it = gw; it < nitems; it += ngw) transpose_item(d, scr, it, lane); }
        cvt_rows(KIN(0), (bf16*)(ws + WS_XB), (size_t)T_TOK * DM, gw * 64 + lane, ngw * 64);
        cvt_rows(KIN(1), (bf16*)(ws + WS_PB), (size_t)DEPTH * T_TOK * PLE, gw * 64 + lane, ngw * 64);
    }
    SEAM();

    const int G0 = G, bx0 = bx, vcu0 = vcu; const XcdBarrier bar0 = bar;
    for (int hl = 0; hl < 2 * DEPTH; ++hl) {
        int G = G0, bx = bx0, vcu = vcu0; XcdBarrier bar = bar0;
        asm volatile("" : "+s"(G), "+s"(bx), "+s"(vcu), "+s"(bar.bar), "+s"(bar.x), "+s"(bar.st));
        const int layer = hl >> 1, second = hl & 1, mix = layer % 3, mj = layer / 3;
        if (RUN) {
            unsigned char* const ws = KWS(); unsigned char* const lw = ws + WS_W + (size_t)layer * LW_BYTES;
            pg8::Gemm g{(const bf16*)(ws + WS_XB), (const bf16*)(lw + (second ? LW_F2IN : LW_F1IN)), T_TOK, 2 * FF, DM}; pg8::StaticOrder S; S.init(T_TOK, 2 * FF, G, bx);
            pg8::EpiSwiGLU E{(bf16*)(ws + WS_H), FF};
            pg8::gemm_phase<pg8::EpiSwiGLU, pg8::StaticOrder, PG8_ALIGN, PG8_SP2>(ldsl + RING_OFF, g, S, E);
        }
        SEAM();
        if (RUN) {
            unsigned char* const ws = KWS(); unsigned char* const lw = ws + WS_W + (size_t)layer * LW_BYTES;
            const float* const resid0 = (hl == 0) ? KIN(0) : (const float*)(ws + WS_X);
            pg8::Gemm g{(const bf16*)(ws + WS_H), (const bf16*)(lw + (second ? LW_F2OUT : LW_F1OUT)), T_TOK, DM, FF}; pg8::StaticOrder S; S.init(T_TOK, DM, G, bx);
            pg8::EpiZ E{resid0, (float*)(ws + WS_Z), DM, ALPHA, 0.5f};
            pg8::gemm_phase<pg8::EpiZ, pg8::StaticOrder, PG8_ALIGN, PG8_SP2>(ldsl + RING_OFF, g, S, E);
        }
        SEAM();
        if (RUN) { TIDS(); unsigned char* const ws = KWS(); const size_t lo_ = ((size_t)layer * 4 + (second ? 2 : 0)) * DM;
            ln_phase((const float*)(ws + WS_Z), KIN(6) + lo_, KIN(7) + lo_, (float*)(ws + WS_X), (bf16*)(ws + WS_XB), gw, ngw, lane); }
        SEAM();
        if (!second) {
            const int n_in = (mix == 2) ? NC_IN_PAD : NA_IN;
            if (RUN) {
                unsigned char* const ws = KWS(); unsigned char* const mb = ws + WS_MIX;
                const bf16* const w_in = (const bf16*)(mix == 0 ? mb + (size_t)mj * MW_A_STRIDE + MW_A_IN : mix == 1 ? mb + MW_B_IN : mb + MW_C_IN);
                { pg8::Gemm g{(const bf16*)(ws + WS_XB), w_in, T_TOK, n_in, DM}; pg8::StaticOrder S; S.init(T_TOK, n_in, G, bx);
                  pg8::EpiBf16<0> E{(bf16*)(ws + WS_QKV), n_in, nullptr, 0, 0, 1.f};
                  pg8::gemm_phase<pg8::EpiBf16<0>, pg8::StaticOrder, PG8_ALIGN, PG8_SP2>(ldsl + RING_OFF, g, S, E); }
                { pg8::Gemm g{(const bf16*)(ws + WS_PB) + (size_t)layer * T_TOK * PLE, (const bf16*)(ws + WS_W + (size_t)layer * LW_BYTES + LW_PP), T_TOK, DM, PLE}; pg8::StaticOrder S; S.init(T_TOK, DM, G, bx);
                  pg8::EpiF32 E{(float*)(ws + WS_PP), DM};
                  pg8::gemm_phase<pg8::EpiF32, pg8::StaticOrder, PG8_ALIGN, PG8_SP2>(ldsl + RING_OFF, g, S, E); }
            }
            SEAM();
            if (mix == 0) {
                if (RUN) { unsigned char* const ws = KWS();
                    att::attn_phase<0>((char*)lds + RING_OFF, (const bf16*)(ws + WS_QKV), NA_IN, (bf16*)(ws + WS_OP), 4096, ws + WS_RM, (const unsigned*)(ws + WS_SEL), 32, bx, G); }
                SEAM();
                if (RUN) { TIDS(); unsigned char* const ws = KWS();
                    diff_combine_phase((const bf16*)(ws + WS_OP), (bf16*)(ws + WS_AO), KIN(12) + mj * 128, KIN(13) + mj * 128, KIN(14) + mj * 128, KIN(15) + mj * 128, KIN(16) + mj * 256,
                                       0.8f - 0.6f * expf(-0.3f * (float)layer), gw, ngw, lane); }
                SEAM();
            } else if (mix == 1) {
                if (RUN) { TIDS(); unsigned char* const ws = KWS(); moba_gate_phase((const bf16*)(ws + WS_QKV), ws + WS_RM, ldsl + RING_OFF, vcu, G, tid); }
                SEAM();
                if (RUN) { unsigned char* const ws = KWS();
                    att::attn_phase<1>((char*)lds + RING_OFF, (const bf16*)(ws + WS_QKV), NA_IN, (bf16*)(ws + WS_AO), DM, ws + WS_RM, (const unsigned*)(ws + WS_SEL), 16, bx, G); }
                SEAM();
            } else {
                if (RUN) { TIDS(); unsigned char* const ws = KWS(); dsa_index_phase((const bf16*)(ws + WS_QKV), (unsigned*)(ws + WS_SEL), gw, ngw, lane); }
                SEAM();
                if (RUN) { unsigned char* const ws = KWS();
                    att::attn_phase<2>((char*)lds + RING_OFF, (const bf16*)(ws + WS_QKV), NC_IN_PAD, (bf16*)(ws + WS_AO), DM, ws + WS_RM, (const unsigned*)(ws + WS_SEL), 16, bx, G); }
                SEAM();
            }
            if (RUN) {
                unsigned char* const ws = KWS(); unsigned char* const mb = ws + WS_MIX;
                const bf16* const w_out = (const bf16*)(mix == 0 ? mb + (size_t)mj * MW_A_STRIDE + MW_A_OUT : mix == 1 ? mb + MW_B_OUT : mb + MW_C_OUT);
                pg8::Gemm g{(const bf16*)(ws + WS_AO), w_out, T_TOK, DM, DM}; pg8::StaticOrder S; S.init(T_TOK, DM, G, bx);
                pg8::EpiZ E{(const float*)(ws + WS_X), (float*)(ws + WS_Z), DM, ALPHA, 1.0f};
                pg8::gemm_phase<pg8::EpiZ, pg8::StaticOrder, PG8_ALIGN, PG8_SP2>(ldsl + RING_OFF, g, S, E);
            }
            SEAM();
            if (RUN) { TIDS(); unsigned char* const ws = KWS(); const size_t lo_ = ((size_t)layer * 4 + 1) * DM;
                ln_phase((const float*)(ws + WS_Z), KIN(6) + lo_, KIN(7) + lo_, (float*)(ws + WS_X), (bf16*)(ws + WS_XB), gw, ngw, lane); }
            SEAM();
        } else {
            if (RUN) {
                unsigned char* const ws = KWS();
                pg8::Gemm g{(const bf16*)(ws + WS_XB), (const bf16*)(ws + WS_W + (size_t)layer * LW_BYTES + LW_PG), T_TOK, DM, DM}; pg8::StaticOrder S; S.init(T_TOK, DM, G, bx);
                pg8::EpiPle E{(const float*)(ws + WS_X), (const float*)(ws + WS_PP), (float*)(ws + WS_Z), DM, ALPHA};
                pg8::gemm_phase<pg8::EpiPle, pg8::StaticOrder, PG8_ALIGN, PG8_SP2>(ldsl + RING_OFF, g, S, E);
            }
            SEAM();
            if (RUN) { TIDS(); unsigned char* const ws = KWS(); const size_t lo_ = ((size_t)layer * 4 + 3) * DM; const bool fin = layer == DEPTH - 1;
                ln_phase((const float*)(ws + WS_Z), KIN(6) + lo_, KIN(7) + lo_, fin ? KOUT() : (float*)(ws + WS_X), fin ? (bf16*)nullptr : (bf16*)(ws + WS_XB), gw, ngw, lane); }
            SEAM();
        }
    }
#undef RUN
#undef SEAM
}

extern "C" void kernel_launch(void* const* d_in, const int* in_sizes, int n_in, void* d_out, int out_size, void* d_ws, size_t ws_size, hipStream_t stream) {
    static int grid = 0;
    if (grid == 0) {
        if (n_in != 21 || in_sizes[0] != T_TOK * DM || out_size != T_TOK * DM || ws_size < WS_END) {
            fprintf(stderr, "kernel_launch: shape/workspace mismatch (n_in %d, in0 %d, out %d, ws %zu, need %zu); nothing launched\n", n_in, n_in > 0 ? in_sizes[0] : -1, out_size, ws_size, (size_t)WS_END); grid = -1; return; }
        int dev = 0, cus = 0, per_cu = 0;
        if (hipGetDevice(&dev) != hipSuccess || hipDeviceGetAttribute(&cus, hipDeviceAttributeMultiprocessorCount, dev) != hipSuccess) { fprintf(stderr, "kernel_launch: device query failed\n"); grid = -1; return; }
        if (hipFuncSetAttribute((const void*)mega_fwd, hipFuncAttributeMaxDynamicSharedMemorySize, LDS_BYTES) != hipSuccess) { fprintf(stderr, "kernel_launch: hipFuncSetAttribute failed\n"); grid = -1; return; }
        if (hipOccupancyMaxActiveBlocksPerMultiprocessor(&per_cu, (const void*)mega_fwd, NWAVES * 64, LDS_BYTES) != hipSuccess || per_cu < 1)
            fprintf(stderr, "kernel_launch: note: occupancy query reports %d workgroups per CU\n", per_cu);
        (void)hipGetLastError();
        grid = cus;
    }
    if (grid < 0) return;
    if (hipMemsetAsync((char*)d_ws + WS_CTL, 0, CTL_ZERO_BYTES, stream) != hipSuccess) { fprintf(stderr, "kernel_launch: memset failed\n"); return; }
    Args a{};
    for (int i = 0; i < 21; ++i) a.in[i] = (const float*)d_in[i];
    a.out = (float*)d_out; a.ws = (unsigned char*)d_ws;
#if MK_PER_PHASE
    for (int p = 0; p < N_PHASES; ++p) { a.ph_lo = p; a.ph_hi = p + 1; hipLaunchKernelGGL(mega_fwd, dim3(grid), dim3(NWAVES * 64), LDS_BYTES, stream, a); }
#else
    a.ph_lo = 0; a.ph_hi = N_PHASES;
    hipLaunchKernelGGL(mega_fwd, dim3(grid), dim3(NWAVES * 64), LDS_BYTES, stream, a);
#endif
    const hipError_t le = hipPeekAtLastError();
    if (le != hipSuccess) fprintf(stderr, "kernel_launch: launch failed: %s\n", hipGetErrorName(le));
}
```

```cpp
#include <hip/hip_runtime.h>
#include <cstdio>
#include <cstdint>
namespace pg8 {
#define PG8_LAS __attribute__((address_space(3)))
typedef unsigned short bf16_t;
typedef short bf16x8 __attribute__((ext_vector_type(8)));
typedef float f32x4 __attribute__((ext_vector_type(4)));
typedef unsigned u32x4 __attribute__((ext_vector_type(4)));
constexpr int BM = 256, BK = 64, HALF = 128, HTB = HALF * BK * 2  , STAGE_BYTES = 8 * HTB, NXCD = 8, WGM = 8;

__host__ __device__ __forceinline__ int lds_byte(int r, int c) { const int st = (r >> 4) * 2 + (c >> 5), rr = r & 15, cc = c & 31, ob = rr * 64 + cc * 2; return st * 1024 + (ob ^ (((ob >> 9) & 1) << 5)); }
__host__ __device__ __forceinline__ void stage_rc(int b, int& R, int& C) { const int st = b / 1024, sb = b % 1024, swz = sb ^ (((sb >> 9) & 1) << 5); R = (st >> 1) * 16 + swz / 64; C = (st & 1) * 32 + (swz % 64) / 2; }
__host__ __device__ __forceinline__ int perm32(int rho) { const int n = rho >> 4, i = rho & 15; return 8 * (i >> 2) + 4 * n + (i & 3); }

struct Unit { int pm, pn; };
struct Gemm { const bf16_t* A; const bf16_t* Bt; int M, N, K; };

struct StaticOrder {
    int nM, nN, nwg, G, c;
    __host__ __device__ void init(int M, int N, int G_, int c_) { nM = M / BM; nN = N / BM; nwg = nM * nN; G = G_; c = c_; }
    __host__ __device__ bool next(int i, Unit& u) const {
        const long L = (long)i * G + c; if (L >= nwg) return false;
        int wgid = (int)L; { const int q = nwg / NXCD, r = nwg % NXCD, xcd = wgid % NXCD, off = wgid / NXCD; wgid = (xcd < r ? xcd * (q + 1) : r * (q + 1) + (xcd - r) * q) + off; }
        const int nig = WGM * nN, gid = wgid / nig, fm = gid * WGM, gsz = (nM - fm) < WGM ? (nM - fm) : WGM;
        u.pm = fm + ((wgid % nig) % gsz); u.pn = (wgid % nig) / gsz; return true;
    }
    __device__ __forceinline__ void a_ready(const Unit&) const {}
    __device__ __forceinline__ void done(const Unit&) const {}
};

__device__ __forceinline__ unsigned cvt_pk_bf16(float lo, float hi) { unsigned r; asm volatile("v_cvt_pk_bf16_f32 %0, %1, %2" : "=v"(r) : "v"(lo), "v"(hi)); return r; }
typedef float f32x2 __attribute__((ext_vector_type(2)));
__device__ __forceinline__ f32x2 gelu_pk(f32x2 v) {
    const f32x2 av = __builtin_elementwise_abs(v), d = av * 0.2316418882f + 1.0f;
    f32x2 t; t.x = __builtin_amdgcn_rcpf(d.x); t.y = __builtin_amdgcn_rcpf(d.y);
    f32x2 q = t * 0.5307027145f + (-0.7265760135f); q = q * t + 0.7107068705f; q = q * t + (-0.142248368f); q = q * t + 0.127414796f; q = q * t;
    const f32x2 s = (v * v) * (-0.72134752044f);
    f32x2 e; e.x = __builtin_amdgcn_exp2f(s.x); e.y = __builtin_amdgcn_exp2f(s.y);
    const f32x2 m = v * (q * e), r = v - m;
    f32x2 o; o.x = v.x < 0.f ? m.x : r.x; o.y = v.y < 0.f ? m.y : r.y; return o;
}

template <int ACT  > struct EpiBf16 {
    static constexpr bool PERM = true, AFTER_DRAIN = false; static_assert(ACT == 0 || ACT == 1, "EpiBf16: ACT is 0 (none) or 1 (gelu_pk)");
    bf16_t* O; int ldc; const float* bias; int split_cols; size_t split_stride; float scale0;
    __device__ __forceinline__ void operator()(const f32x4 (&acc)[2][2][4][2], const Unit& u, int wr, int wc, int fr, int fq) const {
        const int row0 = u.pm * BM + wr * 64 + fr; int colt = u.pn * BM; bf16_t* base = O;
        float sc = 1.f; if (split_cols) { const int t = colt / split_cols; base += (size_t)t * split_stride; colt -= t * split_cols; if (t == 0) sc = scale0; }
        const int col0 = colt + wc * 32 + 8 * fq, bcol0 = u.pn * BM + wc * 32 + 8 * fq;
        f32x4 bv[2][2];
#pragma unroll
        for (int bj = 0; bj < 2; ++bj)
#pragma unroll
            for (int n = 0; n < 2; ++n) bv[bj][n] = bias ? *(const f32x4*)(bias + bcol0 + bj * HALF + 4 * n) : (f32x4){0.f, 0.f, 0.f, 0.f};
#pragma unroll
        for (int ai = 0; ai < 2; ++ai)
#pragma unroll
            for (int m = 0; m < 4; ++m) { bf16_t* rowp = base + (size_t)(row0 + ai * HALF + m * 16) * ldc + col0;
#pragma unroll
                for (int bj = 0; bj < 2; ++bj) { f32x4 v0 = acc[ai][bj][m][0] + bv[bj][0], v1 = acc[ai][bj][m][1] + bv[bj][1];
                    if (ACT == 1) { f32x2 a = gelu_pk((f32x2){v0[0], v0[1]}), b = gelu_pk((f32x2){v0[2], v0[3]}), c = gelu_pk((f32x2){v1[0], v1[1]}), d = gelu_pk((f32x2){v1[2], v1[3]});
                        v0 = (f32x4){a.x, a.y, b.x, b.y}; v1 = (f32x4){c.x, c.y, d.x, d.y}; }
                    v0 = v0 * sc; v1 = v1 * sc; u32x4 w; w.x = cvt_pk_bf16(v0[0], v0[1]); w.y = cvt_pk_bf16(v0[2], v0[3]); w.z = cvt_pk_bf16(v1[0], v1[1]); w.w = cvt_pk_bf16(v1[2], v1[3]);
                    *(u32x4*)(rowp + bj * HALF) = w; } }
    }
};

struct EpiF32 {
    static constexpr bool PERM = false, AFTER_DRAIN = false;
    float* C; int ldc;
    __device__ __forceinline__ void operator()(const f32x4 (&acc)[2][2][4][2], const Unit& u, int wr, int wc, int fr, int fq) const {
        const int row0 = u.pm * BM + wr * 64 + fr, col0 = u.pn * BM + wc * 32 + 4 * fq;
#pragma unroll
        for (int ai = 0; ai < 2; ++ai)
#pragma unroll
            for (int m = 0; m < 4; ++m) { float* rowp = C + (size_t)(row0 + ai * HALF + m * 16) * ldc + col0;
#pragma unroll
                for (int bj = 0; bj < 2; ++bj)
#pragma unroll
                    for (int n = 0; n < 2; ++n) *(f32x4*)(rowp + bj * HALF + n * 16) = acc[ai][bj][m][n]; }
    }
};
struct EpiZ {
    static constexpr bool PERM = false, AFTER_DRAIN = false;
    const float* resid; float* Z; int ldc; float alpha, s;
    __device__ __forceinline__ void operator()(const f32x4 (&acc)[2][2][4][2], const Unit& u, int wr, int wc, int fr, int fq) const {
        const int row0 = u.pm * BM + wr * 64 + fr, col0 = u.pn * BM + wc * 32 + 4 * fq;
#pragma unroll
        for (int ai = 0; ai < 2; ++ai)
#pragma unroll
            for (int m = 0; m < 4; ++m) { const size_t off = (size_t)(row0 + ai * HALF + m * 16) * ldc + col0;
#pragma unroll
                for (int bj = 0; bj < 2; ++bj)
#pragma unroll
                    for (int n = 0; n < 2; ++n) { const f32x4 x = *(const f32x4*)(resid + off + bj * HALF + n * 16);
                        *(f32x4*)(Z + off + bj * HALF + n * 16) = x * alpha + acc[ai][bj][m][n] * s; }
                if (m & 1) asm volatile("" ::: "memory"); }
    }
};
struct EpiPle {
    static constexpr bool PERM = false, AFTER_DRAIN = false;
    const float* resid; const float* pp; float* Z; int ldc; float alpha;
    __device__ __forceinline__ void operator()(const f32x4 (&acc)[2][2][4][2], const Unit& u, int wr, int wc, int fr, int fq) const {
        const int row0 = u.pm * BM + wr * 64 + fr, col0 = u.pn * BM + wc * 32 + 4 * fq;
#pragma unroll
        for (int ai = 0; ai < 2; ++ai)
#pragma unroll
            for (int m = 0; m < 4; ++m) { const size_t off = (size_t)(row0 + ai * HALF + m * 16) * ldc + col0;
#pragma unroll
                for (int bj = 0; bj < 2; ++bj)
#pragma unroll
                    for (int n = 0; n < 2; ++n) { const f32x4 x = *(const f32x4*)(resid + off + bj * HALF + n * 16); const f32x4 p = *(const f32x4*)(pp + off + bj * HALF + n * 16);
                        const f32x4 a = acc[ai][bj][m][n]; f32x4 sg;
#pragma unroll
                        for (int e = 0; e < 4; ++e) sg[e] = __builtin_amdgcn_rcpf(1.0f + __builtin_amdgcn_exp2f(a[e] * -1.4426950408889634f));
                        *(f32x4*)(Z + off + bj * HALF + n * 16) = x * alpha + sg * p; }
                if (m & 1) asm volatile("" ::: "memory"); }
    }
};
struct EpiSwiGLU {
    static constexpr bool PERM = true, AFTER_DRAIN = false;
    bf16_t* O; int ldc;
    __device__ __forceinline__ void operator()(const f32x4 (&acc)[2][2][4][2], const Unit& u, int wr, int wc, int fr, int fq) const {
        const int row0 = u.pm * BM + wr * 64 + fr, col0 = u.pn * HALF + wc * 32 + 8 * fq;
#pragma unroll
        for (int ai = 0; ai < 2; ++ai)
#pragma unroll
            for (int m = 0; m < 4; ++m) { bf16_t* rowp = O + (size_t)(row0 + ai * HALF + m * 16) * ldc + col0;
                f32x4 h[2];
#pragma unroll
                for (int n = 0; n < 2; ++n) { const f32x4 g = acc[ai][0][m][n], up = acc[ai][1][m][n];
#pragma unroll
                    for (int e = 0; e < 4; ++e) h[n][e] = g[e] * __builtin_amdgcn_rcpf(1.0f + __builtin_amdgcn_exp2f(g[e] * -1.4426950408889634f)) * up[e]; }
                u32x4 w; w.x = cvt_pk_bf16(h[0][0], h[0][1]); w.y = cvt_pk_bf16(h[0][2], h[0][3]); w.z = cvt_pk_bf16(h[1][0], h[1][1]); w.w = cvt_pk_bf16(h[1][2], h[1][3]);
                *(u32x4*)rowp = w; }
    }
};
template <class Epi, class Sched, bool ALIGN_EPI = false, bool SP2 = false>
__device__ __forceinline__ void gemm_phase(PG8_LAS unsigned char* lds, const Gemm g, const Sched& S, const Epi& E) {
    int tid = threadIdx.x; asm volatile("" : "+v"(tid));
    const int wid = __builtin_amdgcn_readfirstlane(tid >> 6), lane = tid & 63, wr = wid >> 2, wc = wid & 3, fr = lane & 15, fq = lane >> 4;
    const int K = g.K, nt = K / BK;
    unsigned voffA[2], voffB[2];
#pragma unroll
    for (int i = 0; i < 2; ++i) { int R, C; stage_rc(tid * 16 + i * 8192, R, C); const int Rb = Epi::PERM ? ((R & ~31) + perm32(R & 31)) : R;
        voffA[i] = (unsigned)(R * K + C) * 2u; voffB[i] = (unsigned)(Rb * K + C) * 2u; }
    const size_t kstep = (size_t)(BK * 2);
    const size_t hstep = (size_t)HALF * K * 2;
    const size_t tstep = 2 * hstep;
    const unsigned ldsw = (unsigned)wid * 1024u;
    const int aoff = lds_byte(wr * 64 + fr, fq * 8), boff = lds_byte(wc * 32 + fr, fq * 8);
#define PG8_SA(b, h) (((b) * 2 + (h)) * HTB)
#define PG8_SB(b, h) ((4 + (b) * 2 + (h)) * HTB)
#define PG8_STAGE(bufoff, gbase, voff) do { _Pragma("unroll") for (int _i = 0; _i < 2; ++_i) \
        __builtin_amdgcn_global_load_lds((const unsigned*)((const char*)(gbase) + (voff)[_i]), (PG8_LAS unsigned*)(lds + (bufoff) + ldsw + _i * 8192), 16, 0, 0); } while (0)
#define PG8_LDA(dst, b, h) do { _Pragma("unroll") for (int m = 0; m < 4; ++m) _Pragma("unroll") for (int k = 0; k < 2; ++k) dst[m][k] = *(const PG8_LAS bf16x8*)(lds + PG8_SA(b, h) + aoff + m * 2048 + k * 1024); } while (0)
#define PG8_LDB(dst, b, h) do { _Pragma("unroll") for (int n = 0; n < 2; ++n) _Pragma("unroll") for (int k = 0; k < 2; ++k) dst[n][k] = *(const PG8_LAS bf16x8*)(lds + PG8_SB(b, h) + boff + n * 2048 + k * 1024); } while (0)
#define PG8_MMA(ai, bj, At, Bt) do { __builtin_amdgcn_s_setprio(1); _Pragma("unroll") for (int m = 0; m < 4; ++m) _Pragma("unroll") for (int n = 0; n < 2; ++n) _Pragma("unroll") for (int k = 0; k < 2; ++k) \
        acc[ai][bj][m][n] = __builtin_amdgcn_mfma_f32_16x16x32_bf16(Bt[n][k], At[m][k], acc[ai][bj][m][n], 0, 0, 0); __builtin_amdgcn_s_setprio(0); } while (0)
#define PG8_WAIT_V(n) asm volatile("s_waitcnt vmcnt(" #n ")" ::: "memory")
#define PG8_WAIT_L(n) asm volatile("s_waitcnt lgkmcnt(" #n ")" ::: "memory")
#define PG8_BAR __builtin_amdgcn_s_barrier()
#define PG8_SCHED __builtin_amdgcn_sched_barrier(0)
    Unit cur, nxt; int ui = 0;
    if (!S.next(0, cur)) return;
    f32x4 acc[2][2][4][2];
#pragma unroll
    for (int a = 0; a < 2; ++a)
#pragma unroll
        for (int b = 0; b < 2; ++b)
#pragma unroll
            for (int m = 0; m < 4; ++m)
#pragma unroll
                for (int n = 0; n < 2; ++n) acc[a][b][m][n] = (f32x4){0.f, 0.f, 0.f, 0.f};
    bf16x8 At[4][2], B0[2][2], B1[2][2];
    const char* cA = (const char*)g.A + (size_t)cur.pm * tstep; const char* cB = (const char*)g.Bt + (size_t)cur.pn * tstep;
    S.a_ready(cur);
    if constexpr (SP2) {
        PG8_STAGE(PG8_SB(0, 0), cB, voffB); PG8_STAGE(PG8_SB(0, 1), cB + hstep, voffB); PG8_STAGE(PG8_SA(0, 0), cA, voffA); PG8_STAGE(PG8_SA(0, 1), cA + hstep, voffA);
        if (wr == 1) PG8_BAR;
        PG8_WAIT_V(2); PG8_BAR;
        PG8_STAGE(PG8_SB(1, 0), cB + kstep, voffB); PG8_STAGE(PG8_SA(1, 0), cA + kstep, voffA); PG8_STAGE(PG8_SB(1, 1), cB + hstep + kstep, voffB);
        PG8_WAIT_V(6); PG8_BAR;
    } else {
        PG8_STAGE(PG8_SB(0, 0), cB, voffB); PG8_STAGE(PG8_SA(0, 0), cA, voffA); PG8_STAGE(PG8_SB(0, 1), cB + hstep, voffB); PG8_STAGE(PG8_SA(0, 1), cA + hstep, voffA);
        if (wr == 1) PG8_BAR;
        PG8_WAIT_V(4); PG8_BAR;
        PG8_STAGE(PG8_SB(1, 0), cB + kstep, voffB); PG8_STAGE(PG8_SA(1, 0), cA + kstep, voffA); PG8_STAGE(PG8_SB(1, 1), cB + hstep + kstep, voffB);
        PG8_WAIT_V(6); PG8_BAR;
    }
    for (;;) {
        const bool has_next = S.next(ui + 1, nxt);
        const char* nA = has_next ? (const char*)g.A + (size_t)nxt.pm * tstep : cA; const char* nB = has_next ? (const char*)g.Bt + (size_t)nxt.pn * tstep : cB;
        for (int t = 0; t < nt; t += 2) {
            const bool last = (t == nt - 2);
            const char* a1 = cA + (size_t)(t + 1) * kstep;
            const char* a2 = last ? nA : cA + (size_t)(t + 2) * kstep; const char* b2 = last ? nB : cB + (size_t)(t + 2) * kstep;
            const char* a3 = a2 + kstep; const char* b3 = b2 + kstep;
            if (last && has_next) S.a_ready(nxt);
            if constexpr (SP2) {
            PG8_LDB(B0, 0, 0); PG8_LDB(B1, 0, 1); PG8_SCHED; PG8_LDA(At, 0, 0); PG8_STAGE(PG8_SA(1, 1), a1 + hstep, voffA);
            PG8_WAIT_V(8); PG8_WAIT_L(0); PG8_BAR; PG8_MMA(0, 0, At, B0); PG8_MMA(0, 1, At, B1); PG8_BAR; PG8_SCHED;
            PG8_LDA(At, 0, 1); PG8_STAGE(PG8_SB(0, 0), b2, voffB); PG8_STAGE(PG8_SB(0, 1), b2 + hstep, voffB); PG8_STAGE(PG8_SA(0, 0), a2, voffA);
            PG8_WAIT_V(8); PG8_WAIT_L(0); PG8_BAR; PG8_MMA(1, 0, At, B0); PG8_MMA(1, 1, At, B1); PG8_BAR; PG8_SCHED;
            PG8_LDB(B0, 1, 0); PG8_LDB(B1, 1, 1); PG8_SCHED; PG8_LDA(At, 1, 0); PG8_STAGE(PG8_SA(0, 1), a2 + hstep, voffA);
            PG8_WAIT_V(8); PG8_WAIT_L(0); PG8_BAR; PG8_MMA(0, 0, At, B0); PG8_MMA(0, 1, At, B1); PG8_BAR; PG8_SCHED;
            PG8_LDA(At, 1, 1); PG8_STAGE(PG8_SB(1, 0), b3, voffB); PG8_STAGE(PG8_SB(1, 1), b3 + hstep, voffB); PG8_STAGE(PG8_SA(1, 0), a3, voffA);
            PG8_WAIT_V(8); PG8_WAIT_L(0); PG8_BAR; PG8_MMA(1, 0, At, B0); PG8_MMA(1, 1, At, B1); PG8_BAR; PG8_SCHED;
            } else {
            PG8_LDB(B0, 0, 0); PG8_SCHED; PG8_LDA(At, 0, 0); PG8_STAGE(PG8_SA(1, 1), a1 + hstep, voffA);
            PG8_WAIT_L(8); PG8_BAR; PG8_WAIT_L(0); PG8_MMA(0, 0, At, B0); PG8_BAR; PG8_SCHED;
            PG8_LDB(B1, 0, 1); PG8_STAGE(PG8_SB(0, 0), b2, voffB);
            PG8_BAR; PG8_WAIT_L(0); PG8_MMA(0, 1, At, B1); PG8_BAR;
            PG8_LDA(At, 0, 1); PG8_STAGE(PG8_SA(0, 0), a2, voffA);
            PG8_BAR; PG8_WAIT_L(0); PG8_MMA(1, 0, At, B0); PG8_BAR; PG8_SCHED;
            PG8_STAGE(PG8_SB(0, 1), b2 + hstep, voffB);
            PG8_WAIT_V(6); PG8_BAR; PG8_MMA(1, 1, At, B1); PG8_BAR;
            PG8_LDB(B0, 1, 0); PG8_SCHED; PG8_LDA(At, 1, 0); PG8_STAGE(PG8_SA(0, 1), a2 + hstep, voffA);
            PG8_WAIT_L(8); PG8_BAR; PG8_WAIT_L(0); PG8_MMA(0, 0, At, B0); PG8_BAR; PG8_SCHED;
            PG8_LDB(B1, 1, 1); PG8_STAGE(PG8_SB(1, 0), b3, voffB);
            PG8_BAR; PG8_WAIT_L(0); PG8_MMA(0, 1, At, B1); PG8_BAR;
            PG8_LDA(At, 1, 1); PG8_STAGE(PG8_SA(1, 0), a3, voffA);
            PG8_BAR; PG8_WAIT_L(0); PG8_MMA(1, 0, At, B0); PG8_BAR; PG8_SCHED;
            PG8_STAGE(PG8_SB(1, 1), b3 + hstep, voffB);
            PG8_WAIT_V(6); PG8_BAR; PG8_MMA(1, 1, At, B1); PG8_BAR;
            }
        }
        if constexpr (ALIGN_EPI) { if (wr == 0) PG8_BAR; }
        if constexpr (!Epi::AFTER_DRAIN) { E(acc, cur, wr, wc, fr, fq); S.done(cur); }
        if (!has_next) break;
#pragma unroll
        for (int a = 0; a < 2; ++a)
#pragma unroll
            for (int b = 0; b < 2; ++b)
#pragma unroll
                for (int m = 0; m < 4; ++m)
#pragma unroll
                    for (int n = 0; n < 2; ++n) acc[a][b][m][n] = (f32x4){0.f, 0.f, 0.f, 0.f};
        cur = nxt; cA = nA; cB = nB; ++ui;
        if constexpr (ALIGN_EPI) { if (wr == 1) PG8_BAR; }
    }
    PG8_WAIT_V(0);
    if constexpr (!ALIGN_EPI) { if (wr == 0) PG8_BAR; }
    PG8_BAR;
    if constexpr (Epi::AFTER_DRAIN) { E.fused(acc, cur, wr, wc, fr, fq, lds, wid, lane); S.done(cur); }
#undef PG8_SA
#undef PG8_SB
#undef PG8_STAGE
#undef PG8_LDA
#undef PG8_LDB
#undef PG8_MMA
#undef PG8_WAIT_V
#undef PG8_WAIT_L
#undef PG8_BAR
#undef PG8_SCHED
}
}
namespace att {
typedef unsigned short bf16;
typedef short bf16x8 __attribute__((ext_vector_type(8)));
typedef short s16x4 __attribute__((ext_vector_type(4)));
typedef float f32x16 __attribute__((ext_vector_type(16)));
typedef float f32x4 __attribute__((ext_vector_type(4)));
typedef unsigned u32x4 __attribute__((ext_vector_type(4)));
typedef unsigned u32x2 __attribute__((ext_vector_type(2)));
constexpr float SCALE = 0.08838834764831845f;
constexpr float THR = 8.f;
constexpr int NW = 8, QBLK = 32, KVBLK = 64, QB = NW * QBLK, D = 128;
constexpr int SHM_V = KVBLK * D * 2, SHM_K = KVBLK * D * 2;
constexpr int LDS_BYTES = 2 * SHM_V + 2 * SHM_K + NW * 64 * 4;
#define KSWZ(row, colB) ((row) * 256 + ((colB) ^ (((row) & 7) << 4)))
#define SBAR() __builtin_amdgcn_sched_barrier(0)
#define ABAR() asm volatile("s_waitcnt lgkmcnt(0)\n\ts_barrier" ::: "memory")
__device__ __forceinline__ int v_st(int k, int c) { const int kk = (k & ~0xC) | ((k & 4) << 1) | ((k & 8) >> 1); return ((kk >> 3) * 4 + (c >> 5)) * 512 + ((kk & 7) * 32 + (c & 31)) * 2; }
__device__ __forceinline__ int v_rd_base(int lane) { return ((lane & 3) << 3) | (((lane >> 2) & 3) << 6) | (((lane >> 4) & 1) << 5) | (((lane >> 5) & 1) << 8); }
constexpr int v_rd_off(int d0, int ks, int half) { return d0 * 512 + ks * 4096 + half * 2048; }
__device__ __forceinline__ int crow(int r, int hi) { return (r & 3) + 8 * (r >> 2) + 4 * hi; }
__device__ __forceinline__ unsigned cvtpk(float lo, float hi) { unsigned r; asm volatile("v_cvt_pk_bf16_f32 %0, %1, %2" : "=v"(r) : "v"(lo), "v"(hi)); return r; }
__device__ __forceinline__ bf16x8 load8(const bf16* p) { return *reinterpret_cast<const bf16x8*>(p); }
__device__ __forceinline__ void mask_causal(f32x16& p0, f32x16& p1, int dq) {
    const float NEG = -__builtin_inff();
#pragma unroll
    for (int r = 0; r < 16; ++r) { const int c = (r & 3) + 8 * (r >> 2); if (dq - c < 0) p0[r] = NEG; if (dq - c - 32 < 0) p1[r] = NEG; }
}
__device__ __forceinline__ void partialSM(f32x16& p0, f32x16& p1, float& m_reg, float& mn, float& alpha) {
    float pmax = p0[0];
#pragma unroll
    for (int r = 1; r < 16; ++r) pmax = fmaxf(pmax, p0[r]);
#pragma unroll
    for (int r = 0; r < 16; ++r) pmax = fmaxf(pmax, p1[r]);
    { auto rr = __builtin_amdgcn_permlane32_swap(__float_as_uint(pmax), __float_as_uint(pmax), false, false);
      pmax = fmaxf(__uint_as_float(rr[0]), __uint_as_float(rr[1])); }
    constexpr float C2 = 1.4426950408889634f * SCALE;
    if (__builtin_expect(__all((pmax - m_reg) * SCALE <= THR), 1)) { mn = m_reg; alpha = 1.f; }
    else { mn = fmaxf(m_reg, pmax); alpha = __builtin_amdgcn_exp2f((m_reg - mn) * C2); m_reg = mn; }
    const float mnL = -mn * C2;
#pragma unroll
    for (int r = 0; r < 16; ++r) p0[r] = fmaf(p0[r], C2, mnL);
#pragma unroll
    for (int r = 0; r < 16; ++r) p1[r] = fmaf(p1[r], C2, mnL);
#pragma unroll
    for (int r = 0; r < 16; ++r) p0[r] = __builtin_amdgcn_exp2f(p0[r]);
}
__device__ __forceinline__ void finishSM(f32x16& p0, f32x16& p1, float alpha, float& l_reg, bf16x8& pa0, bf16x8& pa1, bf16x8& pa2, bf16x8& pa3) {
#pragma unroll
    for (int r = 0; r < 16; ++r) p1[r] = __builtin_amdgcn_exp2f(p1[r]);
    float ps = 0;
#pragma unroll
    for (int r = 0; r < 16; ++r) ps += p0[r];
#pragma unroll
    for (int r = 0; r < 16; ++r) ps += p1[r];
    { auto rr = __builtin_amdgcn_permlane32_swap(__float_as_uint(ps), __float_as_uint(ps), false, false);
      ps = __uint_as_float(rr[0]) + __uint_as_float(rr[1]); }
    l_reg = l_reg * alpha + ps;
#define PK4(P, B_, OUT) do { unsigned a0 = cvtpk(P[B_+0], P[B_+1]), a1 = cvtpk(P[B_+2], P[B_+3]);                          \
        unsigned b0 = cvtpk(P[B_+4], P[B_+5]), b1 = cvtpk(P[B_+6], P[B_+7]);                                             \
        auto r0 = __builtin_amdgcn_permlane32_swap(a0, b0, false, false); auto r1 = __builtin_amdgcn_permlane32_swap(a1, b1, false, false); \
        u32x4 w = {r0[0], r1[0], r0[1], r1[1]}; OUT = *reinterpret_cast<bf16x8*>(&w); } while (0)
    PK4(p0, 0, pa0); PK4(p0, 8, pa1); PK4(p1, 0, pa2); PK4(p1, 8, pa3);
#undef PK4
}
template <int KB, int MODE>
__device__ __forceinline__ void qkt(f32x16& p0, f32x16& p1, const char* K_lds, int r32, int hi, const bf16x8* qr, float base, float slopeS, unsigned w0, unsigned w1) {
    const float NEG = -__builtin_inff();
#pragma unroll
    for (int r = 0; r < 16; ++r) { const int c = (r & 3) + 8 * (r >> 2);
        float b0 = fmaf(slopeS, (float)c, base), b1 = fmaf(slopeS, (float)(c + 32), base);
        if (MODE == 2) { b0 = ((w0 >> c) & 1u) ? b0 : NEG; b1 = ((w1 >> c) & 1u) ? b1 : NEG; }
        p0[r] = b0; p1[r] = b1; }
    const char* kb[4];
#pragma unroll
    for (int dd = 0; dd < 4; ++dd) kb[dd] = K_lds + KB * SHM_K + KSWZ(r32, (dd * 16 + hi * 8) * 2);
#pragma unroll
    for (int d0 = 0; d0 < 8; ++d0) { const char* a = kb[d0 & 3] + (d0 >> 2) * 128;
        bf16x8 b0 = *reinterpret_cast<const bf16x8*>(a);
        bf16x8 b1 = *reinterpret_cast<const bf16x8*>(a + 32 * 256);
        p0 = __builtin_amdgcn_mfma_f32_32x32x16_bf16(b0, qr[d0], p0, 0, 0, 0);
        p1 = __builtin_amdgcn_mfma_f32_32x32x16_bf16(b1, qr[d0], p1, 0, 0, 0); }
}
template <int VB>
__device__ __forceinline__ void pv_tile(f32x16* o, int vb0, bf16x8 pa0, bf16x8 pa1, bf16x8 pa2, bf16x8 pa3) {
#define TRRD(dst, off) asm volatile("ds_read_b64_tr_b16 %0, %1 offset:%2" : "=&v"(dst) : "v"(vb0), "i"(off) : "memory")
#define PV_D0(d0) do { s16x4 l0, l1, l2, l3, h0, h1, h2, h3; constexpr int b_ = VB * SHM_V + v_rd_off(d0, 0, 0); \
        TRRD(l0, b_); TRRD(h0, b_ + 2048); TRRD(l1, b_ + 4096); TRRD(h1, b_ + 6144); TRRD(l2, b_ + 8192); TRRD(h2, b_ + 10240); TRRD(l3, b_ + 12288); TRRD(h3, b_ + 14336); \
        asm volatile("s_waitcnt lgkmcnt(0)" ::: "memory"); SBAR();   \
        o[d0] = __builtin_amdgcn_mfma_f32_32x32x16_bf16(pa0, (bf16x8){l0[0], l0[1], l0[2], l0[3], h0[0], h0[1], h0[2], h0[3]}, o[d0], 0, 0, 0);   \
        o[d0] = __builtin_amdgcn_mfma_f32_32x32x16_bf16(pa1, (bf16x8){l1[0], l1[1], l1[2], l1[3], h1[0], h1[1], h1[2], h1[3]}, o[d0], 0, 0, 0);   \
        o[d0] = __builtin_amdgcn_mfma_f32_32x32x16_bf16(pa2, (bf16x8){l2[0], l2[1], l2[2], l2[3], h2[0], h2[1], h2[2], h2[3]}, o[d0], 0, 0, 0);   \
        o[d0] = __builtin_amdgcn_mfma_f32_32x32x16_bf16(pa3, (bf16x8){l3[0], l3[1], l3[2], l3[3], h3[0], h3[1], h3[2], h3[3]}, o[d0], 0, 0, 0); } while (0)
    PV_D0(0); PV_D0(1); PV_D0(2); PV_D0(3);
#undef PV_D0
#undef TRRD
}
struct Blk { const bf16* Q; const bf16* K; const bf16* V; bf16* O; int P0; float slopeS; const unsigned char* rm; const unsigned* bits; };
struct Seam { bf16x8 qr[8]; bf16x8 st_v0, st_v1, st_k0, st_k1; };
#define ROW(p, k0, rr) ((p) + (size_t)((k0) + (rr)) * pitch + sc)
#define VMW() asm volatile("s_waitcnt vmcnt(0)" ::: "memory")
#define VMWN(n) asm volatile("s_waitcnt vmcnt(%0)" :: "i"(n) : "memory")
#define SLOAD_H(Kp, Vp, k0) do { S.st_v0 = load8(ROW(Vp, k0, sr)); S.st_v1 = load8(ROW(Vp, k0, 32 + sr));              \
                         S.st_k0 = load8(ROW(Kp, k0, sr)); S.st_k1 = load8(ROW(Kp, k0, 32 + sr)); } while (0)
#define SWRITE_HK(bf) do { *(bf16x8*)(K_lds + (bf) * SHM_K + kws) = S.st_k0; *(bf16x8*)(K_lds + (bf) * SHM_K + kws + 32 * 256) = S.st_k1; } while (0)
#define SWRITE_HV(bf) do { *(bf16x8*)(V_lds + (bf) * SHM_V + vst0) = S.st_v0; *(bf16x8*)(V_lds + (bf) * SHM_V + vst1) = S.st_v1; } while (0)
#define SWRITE_H(bf) do { SWRITE_HV(bf); SWRITE_HK(bf); } while (0)
__device__ __forceinline__ void attn_prime(const Blk& cur, int pitch, char* lds, Seam& S) {
    int tid = threadIdx.x; asm volatile("" : "+v"(tid));
    const int wid = __builtin_amdgcn_readfirstlane(tid >> 6), lane = tid & 63, r32 = lane & 31, hi = lane >> 5;
    const int sr = tid >> 4, sc = (tid & 15) * 8, kws = KSWZ(sr, sc * 2); char* K_lds = lds + 2 * SHM_V;
#pragma unroll
    for (int d0 = 0; d0 < 8; ++d0) S.qr[d0] = load8(cur.Q + (size_t)(wid * QBLK + r32) * pitch + d0 * 16 + hi * 8);
    SLOAD_H(cur.K, cur.V, 0); VMW(); SWRITE_HK(0);
    ABAR();
}
template <int MODE>
__device__ __forceinline__ void attn_block(const Blk& cur, const Blk& nxt, int pitch, int opitch, char* lds, Seam& S) {
    int tid = threadIdx.x; asm volatile("" : "+v"(tid));
    const int wid = __builtin_amdgcn_readfirstlane(tid >> 6), lane = tid & 63, r32 = lane & 31, hi = lane >> 5;
    const int NT = (cur.P0 + QB) / KVBLK;
    const int qlo = cur.P0 + wid * QBLK, qm = qlo + r32 - 4 * hi;
    char* V_lds = lds; char* K_lds = lds + 2 * SHM_V;
    float* ws = (float*)(lds + 2 * SHM_V + 2 * SHM_K) + wid * 64; float* li_l = ws, * al_l = ws + 32;
    float m_reg = -1e30f, l_reg = 0; f32x16 o[4] = {};
    const int sr = tid >> 4, sc = (tid & 15) * 8, vst0 = v_st(sr, sc), vst1 = v_st(32 + sr, sc), kws = KSWZ(sr, sc * 2);
    const int vb0 = (int)(uintptr_t)V_lds + v_rd_base(lane);
    const bf16* Kh = cur.K; const bf16* Vh = cur.V;
    const float slopeS = cur.slopeS; const float NEGINF = -__builtin_inff();
    unsigned rmv = 0; if (MODE == 1) rmv = cur.rm[(size_t)(wid * QBLK + r32) * 16];
    const unsigned* bp = cur.bits + (size_t)(wid * QBLK + r32) * 64; u32x2 bw = {0u, 0u};
    if (MODE == 2) bw = *(const u32x2*)bp;
#define RESC(a) do { if (__any((a) < 1.f)) { if (hi == 0) al_l[r32] = (a); asm volatile("s_waitcnt lgkmcnt(0)" ::: "memory");              \
                     _Pragma("unroll") for (int d_ = 0; d_ < 4; ++d_) _Pragma("unroll") for (int r = 0; r < 16; ++r) o[d_][r] *= al_l[crow(r, hi)]; } } while (0)
#define KBASE(t) ((t) * KVBLK)
#define MASKT(P0_, P1_, t) do { if (MODE != 2) { const int kb_ = KBASE(t); if (kb_ + KVBLK - 1 > qlo) mask_causal(P0_, P1_, qm - kb_); } } while (0)
#define QKT(KB, PX0, PX1, t) do { const int kb_ = KBASE(t); float base_ = -slopeS * (float)(qm - kb_);                                     \
        if (MODE == 1) { if (!((rmv >> (kb_ >> 8)) & 1u)) base_ = NEGINF; }                                                                 \
        qkt<KB, MODE>(PX0, PX1, K_lds, r32, hi, S.qr, base_, slopeS, bw[0] >> (4 * hi), bw[1] >> (4 * hi));                                 \
        if (MODE == 2) { if ((t) + 1 < NT) bw = *(const u32x2*)(bp + 2 * ((t) + 1)); } } while (0)
#define SEAM_K0() do { VMWN(8); SWRITE_HK(0); SBAR(); } while (0)
    f32x16 pA0, pA1, pB0, pB1; float mnA, mnB, alA, alB; bf16x8 pa0, pa1, pa2, pa3;
    SWRITE_HV(0); SBAR();
    SLOAD_H(Kh, Vh, KBASE(1));
    SBAR(); QKT(0, pA0, pA1, 0);
    MASKT(pA0, pA1, 0); partialSM(pA0, pA1, m_reg, mnA, alA);
    VMW(); SWRITE_H(1);
    ABAR();
#define HALF_STEP(PX0, PX1, mnX, alX, PY0, PY1, alY, t, KB, VB, SB) do {                                                      \
        SBAR(); QKT(KB, PX0, PX1, t);                                                                                         \
        finishSM(PY0, PY1, alY, l_reg, pa0, pa1, pa2, pa3); SBAR();                                                           \
        if ((t) + 1 < NT) { SLOAD_H(Kh, Vh, KBASE((t) + 1)); SBAR(); }                                                        \
        pv_tile<VB>(o, vb0, pa0, pa1, pa2, pa3); MASKT(PX0, PX1, (t)); partialSM(PX0, PX1, m_reg, mnX, alX);                  \
        ABAR();                                                                                                               \
        if ((t) + 1 < NT) { VMW(); SWRITE_H(SB); }                                                                            \
        RESC(alX); ABAR(); } while (0)
    for (int t = 1; t + 1 < NT; t += 2) {
        HALF_STEP(pB0, pB1, mnB, alB, pA0, pA1, alA, t, 1, 0, 0);
        HALF_STEP(pA0, pA1, mnA, alA, pB0, pB1, alB, t + 1, 0, 1, 1);
    }
    SBAR(); QKT(1, pB0, pB1, NT - 1); SBAR();
    SLOAD_H(nxt.K, nxt.V, 0); SBAR();
#pragma unroll
    for (int d0 = 0; d0 < 8; ++d0) S.qr[d0] = load8(nxt.Q + (size_t)(wid * QBLK + r32) * pitch + d0 * 16 + hi * 8);
    SBAR();
    finishSM(pA0, pA1, alA, l_reg, pa0, pa1, pa2, pa3); SBAR();
    pv_tile<0>(o, vb0, pa0, pa1, pa2, pa3);
    MASKT(pB0, pB1, NT - 1); partialSM(pB0, pB1, m_reg, mnB, alB); ABAR(); RESC(alB);
    finishSM(pB0, pB1, alB, l_reg, pa0, pa1, pa2, pa3); SBAR(); pv_tile<1>(o, vb0, pa0, pa1, pa2, pa3);
    SBAR(); SEAM_K0();
    if (hi == 0) li_l[r32] = l_reg; asm volatile("s_waitcnt lgkmcnt(0)" ::: "memory");
    float rli[16];
#pragma unroll
    for (int r = 0; r < 16; ++r) rli[r] = __builtin_amdgcn_rcpf(li_l[crow(r, hi)]);
    bf16* Ow = cur.O + (size_t)(wid * QBLK) * opitch;
#pragma unroll
    for (int r = 0; r < 16; ++r) { const int orow = crow(r, hi);
#pragma unroll
        for (int d0 = 0; d0 < 4; ++d0) { const float v = o[d0][r] * rli[r];
            const float vn = __int_as_float(__builtin_amdgcn_update_dpp(0, __float_as_int(v), 0xB1, 0xf, 0xf, true));
            if ((r32 & 1) == 0) *(unsigned*)(Ow + (size_t)orow * opitch + d0 * 32 + r32) = cvtpk(v, vn); } }
    ABAR();
#undef RESC
#undef KBASE
#undef MASKT
#undef QKT
#undef SEAM_K0
#undef HALF_STEP
}
#undef ROW
#undef SLOAD_H
#undef SWRITE_HK
#undef SWRITE_HV
#undef SWRITE_H
template <int MODE>
__device__ __forceinline__ Blk make_blk(int L, int pass, int total, const bf16* QKV, int pitch, bf16* Obuf, int opitch, const unsigned char* rowmask, const unsigned* selbits) {
    const int v = (L & 7) * (total >> 3) + (L >> 3);
    const int bh = v >> 2, x = v & 3, qb = pass ? 7 - x : x;
    const int nh = total >> 4, b = bh / nh, hh = bh - b * nh;
    const size_t row0 = (size_t)b * 2048 + (size_t)qb * QB;
    int qcol, kcol, vcol, ocol; float slope;
    if (MODE == 0) { const int h = hh >> 2, m = (hh >> 1) & 1, vf = hh & 1; qcol = h * 256 + m * 128; kcol = 2048 + qcol; vcol = 4096 + h * 256 + vf * 128; ocol = (h * 2 + m) * 256 + vf * 128; slope = __builtin_amdgcn_exp2f(-(float)(h + 1)); }
    else if (MODE == 1) { qcol = hh * 128; kcol = 2048 + qcol; vcol = 4096 + qcol; ocol = qcol; slope = __builtin_amdgcn_exp2f(-0.5f * (float)(hh + 1)); }
    else { const int g = hh >> 2; qcol = hh * 128; kcol = 2048 + g * 128; vcol = 2560 + g * 128; ocol = qcol; slope = __builtin_amdgcn_exp2f(-0.5f * (float)(hh + 1)); }
    Blk r;
    r.Q = QKV + row0 * pitch + qcol; r.K = QKV + (size_t)b * 2048 * pitch + kcol; r.V = QKV + (size_t)b * 2048 * pitch + vcol;
    r.O = Obuf + row0 * opitch + ocol; r.P0 = qb * QB; r.slopeS = slope * (1.0f / SCALE);
    r.rm = rowmask + row0 * 16 + hh; r.bits = selbits + row0 * 64;
    return r;
}
template <int MODE>
__device__ __forceinline__ void attn_phase(char* lds, const bf16* QKV, int pitch, bf16* Obuf, int opitch, const unsigned char* rowmask, const unsigned* selbits, int nheads, int blk, int G) {
    const int total = 16 * nheads;
    int L = blk; if (L >= total) return;
    int pass = 0;
    Blk cur = make_blk<MODE>(L, 0, total, QKV, pitch, Obuf, opitch, rowmask, selbits);
    Seam S;
    attn_prime(cur, pitch, lds, S);
    for (;;) {
        const bool more_pass = pass == 0, more_item = L + G < total, last = !more_pass && !more_item;
        int passn = pass + 1, Ln = L;
        if (!more_pass) { passn = 0; Ln = more_item ? L + G : L; }
        const Blk nxt = last ? cur : make_blk<MODE>(Ln, passn, total, QKV, pitch, Obuf, opitch, rowmask, selbits);
        attn_block<MODE>(cur, nxt, pitch, opitch, lds, S);
        if (last) break;
        cur = nxt; pass = passn; L = Ln;
    }
}
#undef SBAR
#undef ABAR
#undef VMW
#undef VMWN
#undef KSWZ
}
#ifndef PG8_SP2
#define PG8_SP2 true
#endif
#ifndef PG8_ALIGN
#define PG8_ALIGN true
#endif
#ifndef MK_PER_PHASE
#define MK_PER_PHASE 0
#endif
constexpr int NWAVES = 8;
constexpr int T_TOK = 8192, SEQ = 2048, DM = 2048, FF = 5632, PLE = 256, DEPTH = 4;
constexpr int NA_IN = 6144, NC_IN_PAD = 4352, NC_IN = 4176;
constexpr float LN_EPS = 1e-5f, RMS_EPS = 1e-6f;
constexpr float ALPHA = 1.681792830507429f;
constexpr size_t MiB = 1u << 20;
constexpr size_t WS_CTL = 0, CTL_ZERO_BYTES = 1 * MiB;
constexpr size_t WS_W = 1 * MiB;
constexpr size_t LW_F1IN = 0, LW_F1OUT = 44 * MiB, LW_F2IN = 66 * MiB, LW_F2OUT = 110 * MiB, LW_PG = 132 * MiB, LW_PP = 140 * MiB, LW_BYTES = 141 * MiB;
constexpr size_t WS_MIX = WS_W + 4 * LW_BYTES;
constexpr size_t MW_A_IN = 0, MW_A_OUT = 24 * MiB, MW_A_STRIDE = 32 * MiB, MW_B_IN = 64 * MiB, MW_B_OUT = 88 * MiB, MW_C_IN = 96 * MiB, MW_C_OUT = 113 * MiB, MW_BYTES = 121 * MiB;
constexpr size_t WS_X = WS_MIX + MW_BYTES;
constexpr size_t WS_Z = WS_X + 64 * MiB;
constexpr size_t WS_XB = WS_Z + 64 * MiB;
constexpr size_t WS_H = WS_XB + 32 * MiB;
constexpr size_t WS_QKV = WS_H + 88 * MiB;
constexpr size_t WS_AO = WS_QKV + 96 * MiB;
constexpr size_t WS_OP = WS_AO + 32 * MiB;
constexpr size_t WS_PP = WS_OP + 64 * MiB;
constexpr size_t WS_PB = WS_PP + 64 * MiB;
constexpr size_t WS_SEL = WS_PB + 16 * MiB;
constexpr size_t WS_RM = WS_SEL + 2 * MiB;
constexpr size_t WS_END = WS_RM + 1 * MiB;
constexpr int CW_TMO = 0, CW_CODE = 1, CW_BAR = 4096;
constexpr int RING_OFF = 0, RING_BYTES = 131072;
constexpr int LDSCTL_OFF = RING_BYTES, MISC_OFF = LDSCTL_OFF + 320;
constexpr int LDS_BYTES = 147456;
static_assert(MISC_OFF + 128 <= LDS_BYTES && att::LDS_BYTES <= RING_BYTES, "LDS map");
#define GAS __attribute__((address_space(1)))
#define LAS __attribute__((address_space(3)))
typedef unsigned short bf16;
typedef unsigned v4u __attribute__((ext_vector_type(4)));
typedef float f32x4 __attribute__((ext_vector_type(4)));
typedef short bf16x8 __attribute__((ext_vector_type(8)));
typedef GAS unsigned gu32;
typedef GAS unsigned long long gu64;
#define RLX_AGENT __ATOMIC_RELAXED, __HIP_MEMORY_SCOPE_AGENT
#define LDS_WAIT() asm volatile("s_waitcnt lgkmcnt(0)" ::: "memory")
#define VM_WAIT() asm volatile("s_waitcnt vmcnt(0)" ::: "memory")
__device__ __forceinline__ unsigned long long rt() { return __builtin_amdgcn_s_memrealtime(); }
__device__ __forceinline__ unsigned f2bf(float f) { unsigned u = __builtin_bit_cast(unsigned, f); return (u + 0x7fffu + ((u >> 16) & 1u)) >> 16; }
__device__ __forceinline__ unsigned pk2(float lo, float hi) { return f2bf(lo) | (f2bf(hi) << 16); }
#define XB_TMO      128
#define XB_XCNT(j)  (256  + 64 * (j))
#define XB_XSUB(j)  (1280 + 64 * (j))
#define XB_XGEN(j)  (2304 + 64 * (j))
#define XB_TOP      3328
#define XB_TOPGEN   3392
#define XCD_BAR_WORDS 3456
#define XB_SPIN_CAP (1u << 18)

__device__ __forceinline__ unsigned xb_ld(unsigned* p)              { return __hip_atomic_load((GAS unsigned*)p, __ATOMIC_RELAXED, __HIP_MEMORY_SCOPE_AGENT); }
__device__ __forceinline__ unsigned xb_add(unsigned* p, unsigned v) { return __hip_atomic_fetch_add((GAS unsigned*)p, v, __ATOMIC_RELAXED, __HIP_MEMORY_SCOPE_AGENT); }
__device__ __forceinline__ unsigned xb_xcc_id() { return (unsigned)__builtin_amdgcn_s_getreg((3 << 11) | 20) & 0xFu; }
#define XB_SPIN(cond, bar) do { unsigned _sp = 0; while (cond) { __builtin_amdgcn_s_sleep(1); \
    if ((++_sp & 255u) == 0u) { if (xb_ld(&(bar)[XB_TMO])) break; if (_sp > XB_SPIN_CAP) { (void)xb_add(&(bar)[XB_TMO], 1u); break; } } } } while (0)

struct XcdBarrier {
    unsigned* bar; unsigned x;
    volatile LAS unsigned* st;
};

__device__ __forceinline__ XcdBarrier xcd_barrier_post(unsigned* bar, volatile LAS unsigned* st) {
    XcdBarrier b; b.bar = bar; b.x = xb_xcc_id(); b.st = st;
    if (threadIdx.x == 0) (void)xb_add(&bar[XB_XCNT(b.x)], 1u);
    return b;
}
__device__ __forceinline__ void xcd_barrier_complete(unsigned* bar, unsigned x, unsigned& nloc, unsigned& nx) {
    const unsigned G = gridDim.x * gridDim.y * gridDim.z;
    unsigned sum, cnt, mine, sp = 0u;
    for (;;) {
        sum = 0u; cnt = 0u; mine = 0u;
#pragma unroll
        for (unsigned j = 0; j < 16; ++j) { const unsigned c = xb_ld(&bar[XB_XCNT(j)]); sum += c; cnt += (c > 0u) ? 1u : 0u; mine = (j == x) ? c : mine; }
        if (sum == G) break;
        __builtin_amdgcn_s_sleep(1);
        if ((++sp & 255u) == 0u) { if (xb_ld(&bar[XB_TMO])) break; if (sp > XB_SPIN_CAP) { (void)xb_add(&bar[XB_TMO], 1u); break; } }
    }
    nloc = mine > 0u ? mine : 1u; nx = cnt > 0u ? cnt : 1u;
}

__device__ __forceinline__ void xcd_barrier(const XcdBarrier& b) {
    asm volatile("s_waitcnt vmcnt(0)" ::: "memory");
    __syncthreads();
    if (threadIdx.x == 0) {
        unsigned* bar = b.bar;
        __builtin_amdgcn_s_waitcnt(0);
        unsigned nloc = b.st[0], nx = b.st[1];
        if (nloc == 0u) { xcd_barrier_complete(bar, b.x, nloc, nx); b.st[0] = nloc; b.st[1] = nx; }
        const unsigned old = xb_add(&bar[XB_XSUB(b.x)], 1u);
        const unsigned gen = old / nloc;
        if (old + 1u == (gen + 1u) * nloc) {
            __builtin_amdgcn_fence(__ATOMIC_RELEASE, "agent");
            asm volatile("s_waitcnt vmcnt(0)" ::: "memory");
            const unsigned og = xb_add(&bar[XB_TOP], 1u);
            const unsigned tg = og / nx;
            if (og + 1u == (tg + 1u) * nx) xb_add(&bar[XB_TOPGEN], 1u);
            else XB_SPIN(xb_ld(&bar[XB_TOPGEN]) == tg, bar);
            __builtin_amdgcn_fence(__ATOMIC_ACQUIRE, "agent");
            xb_add(&bar[XB_XGEN(b.x)], 1u);
            asm volatile("s_waitcnt vmcnt(0)" ::: "memory");
        } else {
            XB_SPIN(xb_ld(&bar[XB_XGEN(b.x)]) == gen, bar);
            __builtin_amdgcn_fence(__ATOMIC_ACQUIRE, "agent");
            asm volatile("s_waitcnt vmcnt(0)" ::: "memory");
        }
    }
    __syncthreads();
}
typedef unsigned u32x2 __attribute__((ext_vector_type(2)));
typedef float f32x16 __attribute__((ext_vector_type(16)));
__device__ __forceinline__ unsigned cvtpk2(float lo, float hi) { unsigned r; asm volatile("v_cvt_pk_bf16_f32 %0, %1, %2" : "=v"(r) : "v"(lo), "v"(hi)); return r; }
__device__ __forceinline__ float bf2f(unsigned short h) { return __uint_as_float((unsigned)h << 16); }
template <int M> __device__ __forceinline__ int swz_xor_i(int v) {
    if (M == 1) return __builtin_amdgcn_update_dpp(v, v, 0xB1, 0xf, 0xf, true);
    else if (M == 2) return __builtin_amdgcn_update_dpp(v, v, 0x4E, 0xf, 0xf, true);
    else return __builtin_amdgcn_ds_swizzle(v, (M << 10) | 0x1f);
}
template <int M> __device__ __forceinline__ float swz_xor(float v) { return __int_as_float(swz_xor_i<M>(__float_as_int(v))); }
__device__ __forceinline__ float wave_sum(float v) {
    v += swz_xor<1>(v); v += swz_xor<2>(v); v += swz_xor<4>(v); v += swz_xor<8>(v); v += swz_xor<16>(v);
    auto rr = __builtin_amdgcn_permlane32_swap(__float_as_uint(v), __float_as_uint(v), false, false);
    return __uint_as_float(rr[0]) + __uint_as_float(rr[1]);
}
struct WDesc { const float* src; bf16* dst; int K, N, Npad, mode; };
__device__ __forceinline__ void transpose_item(const WDesc& d, LAS unsigned* scr, int item, int lane) {
    const int nblk = d.Npad >> 6, kb = item / nblk, nb = item - kb * nblk, k0 = 64 * kb, n0 = 64 * nb;
    const int c4 = lane & 15, rr = lane >> 4, nn = n0 + 4 * c4; const bool ok = nn < d.N;
    const float* sp = d.src + (size_t)(k0 + 2 * rr) * d.N + nn;
    f32x4 va[8], vb[8];
#pragma unroll
    for (int i = 0; i < 8; ++i) { va[i] = ok ? *(const GAS f32x4*)(sp + (size_t)(8 * i) * d.N) : (f32x4){0.f, 0.f, 0.f, 0.f}; vb[i] = ok ? *(const GAS f32x4*)(sp + (size_t)(8 * i + 1) * d.N) : (f32x4){0.f, 0.f, 0.f, 0.f}; }
#pragma unroll
    for (int i = 0; i < 8; ++i)
#pragma unroll
        for (int e = 0; e < 4; ++e) scr[(4 * c4 + e) * 33 + 4 * i + rr] = cvtpk2(va[i][e], vb[i][e]);
    LDS_WAIT(); asm volatile("" ::: "memory");
    int drow0 = n0;
    if (d.mode == 1) { const int bj = n0 >= FF ? 1 : 0, cc = n0 - bj * FF; drow0 = 256 * (cc >> 7) + 128 * bj + (cc & 127); }
    const int c = lane & 7;
#pragma unroll
    for (int j = 0; j < 8; ++j) { const int n = (lane >> 3) + 8 * j; const LAS unsigned* s = scr + n * 33 + 4 * c;
        v4u o; o.x = s[0]; o.y = s[1]; o.z = s[2]; o.w = s[3];
        *(GAS v4u*)(d.dst + (size_t)(drow0 + n) * d.K + k0 + 8 * c) = o; }
    LDS_WAIT(); asm volatile("" ::: "memory");
}
struct Args { const float* in[21]; float* out; unsigned char* ws; int ph_lo, ph_hi; };
__device__ __forceinline__ const void* karg_ptr(unsigned off);
__device__ __forceinline__ WDesc wdesc(unsigned char* ws, int mi) {
    WDesc d; d.mode = 0;
    if (mi < 24) { const int l = mi / 6, k = mi - 6 * l; unsigned char* lb = ws + WS_W + (size_t)l * LW_BYTES;
        if (k == 0)      { d.src = ((const float*)karg_ptr(8u * 2)) + (size_t)l * DM * 2 * FF; d.dst = (bf16*)(lb + LW_F1IN);  d.K = DM;  d.N = 2 * FF; d.mode = 1; }
        else if (k == 1) { d.src = ((const float*)karg_ptr(8u * 3)) + (size_t)l * FF * DM;     d.dst = (bf16*)(lb + LW_F1OUT); d.K = FF;  d.N = DM; }
        else if (k == 2) { d.src = ((const float*)karg_ptr(8u * 4)) + (size_t)l * DM * 2 * FF; d.dst = (bf16*)(lb + LW_F2IN);  d.K = DM;  d.N = 2 * FF; d.mode = 1; }
        else if (k == 3) { d.src = ((const float*)karg_ptr(8u * 5)) + (size_t)l * FF * DM;     d.dst = (bf16*)(lb + LW_F2OUT); d.K = FF;  d.N = DM; }
        else if (k == 4) { d.src = ((const float*)karg_ptr(8u * 8)) + (size_t)l * DM * DM;     d.dst = (bf16*)(lb + LW_PG);    d.K = DM;  d.N = DM; }
        else             { d.src = ((const float*)karg_ptr(8u * 9)) + (size_t)l * PLE * DM;    d.dst = (bf16*)(lb + LW_PP);    d.K = PLE; d.N = DM; }
        d.Npad = d.N; return d; }
    unsigned char* mb = ws + WS_MIX; const int k = mi - 24;
    if (k == 0)      { d.src = ((const float*)karg_ptr(8u * 10));                         d.dst = (bf16*)(mb + MW_A_IN);                d.K = DM; d.N = NA_IN; }
    else if (k == 1) { d.src = ((const float*)karg_ptr(8u * 11));                         d.dst = (bf16*)(mb + MW_A_OUT);               d.K = DM; d.N = DM; }
    else if (k == 2) { d.src = ((const float*)karg_ptr(8u * 10)) + (size_t)DM * NA_IN;    d.dst = (bf16*)(mb + MW_A_STRIDE + MW_A_IN);  d.K = DM; d.N = NA_IN; }
    else if (k == 3) { d.src = ((const float*)karg_ptr(8u * 11)) + (size_t)DM * DM;       d.dst = (bf16*)(mb + MW_A_STRIDE + MW_A_OUT); d.K = DM; d.N = DM; }
    else if (k == 4) { d.src = ((const float*)karg_ptr(8u * 17));                         d.dst = (bf16*)(mb + MW_B_IN);                d.K = DM; d.N = NA_IN; }
    else if (k == 5) { d.src = ((const float*)karg_ptr(8u * 18));                         d.dst = (bf16*)(mb + MW_B_OUT);               d.K = DM; d.N = DM; }
    else if (k == 6) { d.src = ((const float*)karg_ptr(8u * 19));                         d.dst = (bf16*)(mb + MW_C_IN);                d.K = DM; d.N = NC_IN; d.Npad = NC_IN_PAD; return d; }
    else             { d.src = ((const float*)karg_ptr(8u * 20));                         d.dst = (bf16*)(mb + MW_C_OUT);               d.K = DM; d.N = DM; }
    d.Npad = d.N; return d;
}
constexpr int N_WMATS = 32;
__device__ __forceinline__ void cvt_rows(const float* src, bf16* dst, size_t n, int gt, int ngt) {
    for (size_t i = (size_t)gt * 8; i < n; i += (size_t)ngt * 8) { const f32x4 a = *(const GAS f32x4*)(src + i), b = *(const GAS f32x4*)(src + i + 4);
        v4u o; o.x = cvtpk2(a.x, a.y); o.y = cvtpk2(a.z, a.w); o.z = cvtpk2(b.x, b.y); o.w = cvtpk2(b.z, b.w); *(GAS v4u*)(dst + i) = o; }
}
__device__ __forceinline__ void ln_phase(const float* Z, const float* g, const float* b, float* X, bf16* XB, int gw, int ngw, int lane) {
    f32x4 gv[8], bv[8];
#pragma unroll
    for (int j = 0; j < 8; ++j) { gv[j] = *((const GAS f32x4*)g + lane + 64 * j); bv[j] = *((const GAS f32x4*)b + lane + 64 * j); }
    for (int row = gw; row < T_TOK; row += ngw) {
        const GAS f32x4* zr = (const GAS f32x4*)(Z + (size_t)row * DM) + lane;
        f32x4 v[8]; float s = 0.f;
#pragma unroll
        for (int j = 0; j < 8; ++j) { v[j] = zr[64 * j]; s += (v[j].x + v[j].y) + (v[j].z + v[j].w); }
        const float mean = wave_sum(s) * (1.f / DM); float s2 = 0.f;
#pragma unroll
        for (int j = 0; j < 8; ++j) { v[j] = v[j] - mean; s2 += (v[j].x * v[j].x + v[j].y * v[j].y) + (v[j].z * v[j].z + v[j].w * v[j].w); }
        const float rstd = 1.f / sqrtf(wave_sum(s2) * (1.f / DM) + LN_EPS);
        GAS f32x4* xo = (GAS f32x4*)(X + (size_t)row * DM) + lane;
#pragma unroll
        for (int j = 0; j < 8; ++j) { v[j] = v[j] * rstd * gv[j] + bv[j]; xo[64 * j] = v[j]; }
        if (XB) { GAS u32x2* o8 = (GAS u32x2*)(XB + (size_t)row * DM) + lane;
#pragma unroll
            for (int j = 0; j < 8; ++j) { u32x2 w; w.x = cvtpk2(v[j].x, v[j].y); w.y = cvtpk2(v[j].z, v[j].w); o8[64 * j] = w; } }
    }
}
__device__ __forceinline__ void diff_combine_phase(const bf16* OP, bf16* AO, const float* lq1, const float* lk1, const float* lq2, const float* lk2, const float* sg, float lambda_init, int gw, int ngw, int lane) {
    const float s1 = wave_sum(lq1[lane] * lk1[lane] + lq1[lane + 64] * lk1[lane + 64]);
    const float s2 = wave_sum(lq2[lane] * lk2[lane] + lq2[lane + 64] * lk2[lane + 64]);
    const float lam = expf(s1) - expf(s2) + lambda_init;
    const f32x4 gg = *((const GAS f32x4*)sg + lane); const float post = 1.0f - lambda_init;
    for (int row = gw; row < T_TOK; row += ngw) {
        const GAS u32x2* src = (const GAS u32x2*)(OP + (size_t)row * 4096) + lane;
        u32x2 a[8], b[8];
#pragma unroll
        for (int h = 0; h < 8; ++h) { a[h] = src[h * 128]; b[h] = src[h * 128 + 64]; }
#pragma unroll
        for (int h = 0; h < 8; ++h) {
            float d0 = __uint_as_float(a[h].x << 16) - lam * __uint_as_float(b[h].x << 16), d1 = __uint_as_float(a[h].x & 0xffff0000u) - lam * __uint_as_float(b[h].x & 0xffff0000u);
            float d2 = __uint_as_float(a[h].y << 16) - lam * __uint_as_float(b[h].y << 16), d3 = __uint_as_float(a[h].y & 0xffff0000u) - lam * __uint_as_float(b[h].y & 0xffff0000u);
            const float ss = wave_sum((d0 * d0 + d1 * d1) + (d2 * d2 + d3 * d3));
            const float r = post / sqrtf(ss * (1.f / 256.f) + RMS_EPS);
            u32x2 w; w.x = cvtpk2(d0 * r * gg.x, d1 * r * gg.y); w.y = cvtpk2(d2 * r * gg.z, d3 * r * gg.w);
            *((GAS u32x2*)(AO + (size_t)row * DM + h * 256) + lane) = w; }
    }
}
__device__ __forceinline__ void moba_gate_phase(const bf16* QKV, unsigned char* rowmask, LAS unsigned char* ldsb, int vcu, int G, int tid) {
    LAS float* part = (LAS float*)ldsb;
    LAS float* kmean = (LAS float*)(ldsb + 16384);
    for (int u = vcu; u < 512; u += G) {
        const int r = u >> 8, uu = u & 255, b = uu >> 6, h = (uu >> 2) & 15, x = uu & 3, own = r ? 7 - x : x;
        const bf16* Kb = QKV + (size_t)b * SEQ * NA_IN + 2048 + h * 128;
        const int rg = tid >> 4, cc = (tid & 15) * 8;
        for (int n = 0; n < own; ++n) {
            float s[8] = {0.f, 0.f, 0.f, 0.f, 0.f, 0.f, 0.f, 0.f};
#pragma unroll
            for (int i = 0; i < 8; ++i) { const v4u kv = *(const GAS v4u*)(Kb + (size_t)(n * 256 + rg + 32 * i) * NA_IN + cc);
                s[0] += __uint_as_float(kv.x << 16); s[1] += __uint_as_float(kv.x & 0xffff0000u); s[2] += __uint_as_float(kv.y << 16); s[3] += __uint_as_float(kv.y & 0xffff0000u);
                s[4] += __uint_as_float(kv.z << 16); s[5] += __uint_as_float(kv.z & 0xffff0000u); s[6] += __uint_as_float(kv.w << 16); s[7] += __uint_as_float(kv.w & 0xffff0000u); }
#pragma unroll
            for (int k = 0; k < 8; ++k) part[rg * 128 + cc + k] = s[k];
            __syncthreads();
            if (tid < 128) { float t = 0.f;
#pragma unroll 8
                for (int i = 0; i < 32; ++i) t += part[i * 128 + tid];
                kmean[n * 128 + tid] = t * (1.f / 256.f); }
            __syncthreads();
        }
        const int q = tid >> 1, half = tid & 1;
        const size_t qrow = (size_t)b * SEQ + own * 256 + q;
        const bf16* qp = QKV + qrow * NA_IN + h * 128 + half * 64;
        float qv[64];
#pragma unroll
        for (int i = 0; i < 8; ++i) { const v4u kv = *(const GAS v4u*)(qp + 8 * i);
            qv[8 * i + 0] = __uint_as_float(kv.x << 16); qv[8 * i + 1] = __uint_as_float(kv.x & 0xffff0000u); qv[8 * i + 2] = __uint_as_float(kv.y << 16); qv[8 * i + 3] = __uint_as_float(kv.y & 0xffff0000u);
            qv[8 * i + 4] = __uint_as_float(kv.z << 16); qv[8 * i + 5] = __uint_as_float(kv.z & 0xffff0000u); qv[8 * i + 6] = __uint_as_float(kv.w << 16); qv[8 * i + 7] = __uint_as_float(kv.w & 0xffff0000u); }
        float gt[7];
#pragma unroll
        for (int n = 0; n < 7; ++n) { float acc = 0.f;
            if (n < own) {
#pragma unroll
                for (int d4 = 0; d4 < 16; ++d4) { const f32x4 km = *(const LAS f32x4*)(kmean + n * 128 + half * 64 + 4 * d4);
                    acc = fmaf(qv[4 * d4 + 0], km.x, acc); acc = fmaf(qv[4 * d4 + 1], km.y, acc); acc = fmaf(qv[4 * d4 + 2], km.z, acc); acc = fmaf(qv[4 * d4 + 3], km.w, acc); } }
            acc += swz_xor<1>(acc); gt[n] = acc; }
        unsigned m = 0u;
#pragma unroll
        for (int k = 0; k < 3; ++k) { int best = -1; float bv = -__builtin_inff();
#pragma unroll
            for (int n = 0; n < 7; ++n) if (n < own && !((m >> n) & 1u) && gt[n] > bv) { bv = gt[n]; best = n; }
            if (best >= 0) m |= 1u << best; }
        m |= 1u << own;
        if (half == 0) rowmask[qrow * 16 + h] = (unsigned char)m;
        __syncthreads();
    }
}
__device__ __forceinline__ void dsa_index_phase(const bf16* QKV, unsigned* selbits, int gw, int ngw, int lane) {
    typedef short bf16x8 __attribute__((ext_vector_type(8)));
    const int c = lane & 31, hi = lane >> 5;
    for (int id = gw; id < 4096; id += ngw) {
        const int rnd = id / ngw, b = id >> 10, j0 = id & 1023, tp = (rnd & 1) ? 1023 - j0 : j0;
        const size_t row0 = (size_t)b * SEQ + 2 * tp;
        const int ntile = (2 * tp + 1) / 32 + 1, t_me = 2 * tp + hi;
        const int qq = (c >> 2) & 1, head = (c & 3) + 4 * (c >> 3);
        const bf16* ap = QKV + (row0 + qq) * NC_IN_PAD + 3072 + head * 64 + 8 * hi;
        bf16x8 a[4];
#pragma unroll
        for (int s = 0; s < 4; ++s) a[s] = *(const bf16x8*)(ap + 16 * s);
        float wf[16];
        { const bf16* wp = QKV + (row0 + hi) * NC_IN_PAD + 4160; const v4u w0 = *(const GAS v4u*)wp, w1 = *(const GAS v4u*)(wp + 8);
          const unsigned ww[8] = {w0.x, w0.y, w0.z, w0.w, w1.x, w1.y, w1.z, w1.w};
#pragma unroll
          for (int i = 0; i < 8; ++i) { wf[2 * i] = __uint_as_float(ww[i] << 16) * 0.03125f; wf[2 * i + 1] = __uint_as_float(ww[i] & 0xffff0000u) * 0.03125f; } }
        const bf16* kp = QKV + ((size_t)b * SEQ + c) * NC_IN_PAD + 4096 + 8 * hi;
        unsigned u[64];
#pragma unroll
        for (int j = 0; j < 64; ++j) {
            float sc = -__builtin_inff();
            if (j < ntile) {
                bf16x8 bb[4];
#pragma unroll
                for (int s = 0; s < 4; ++s) bb[s] = *(const bf16x8*)(kp + (size_t)j * 32 * NC_IN_PAD + 16 * s);
                f32x16 acc = {};
#pragma unroll
                for (int s = 0; s < 4; ++s) acc = __builtin_amdgcn_mfma_f32_32x32x16_bf16(a[s], bb[s], acc, 0, 0, 0);
                float v = 0.f;
#pragma unroll
                for (int r = 0; r < 16; ++r) v = fmaf(wf[r], fmaxf(acc[r], 0.f), v);
                if (32 * j + c <= t_me) sc = v;
            }
            const unsigned bits = __float_as_uint(sc);
            u[j] = bits ^ ((unsigned)((int)bits >> 31) | 0x80000000u);
        }
        unsigned T = 0u;
        for (int bit = 31; bit >= 0; --bit) {
            const unsigned cand = T | (1u << bit); int cnt = 0;
#pragma unroll
            for (int j = 0; j < 64; ++j) cnt += (u[j] >= cand) ? 1 : 0;
            cnt += swz_xor_i<1>(cnt); cnt += swz_xor_i<2>(cnt); cnt += swz_xor_i<4>(cnt); cnt += swz_xor_i<8>(cnt); cnt += swz_xor_i<16>(cnt);
            if (cnt >= 256) T = cand;
        }
        if (T < 0x00800000u) T = 0x00800000u;
        unsigned mylo = 0u, myhi = 0u;
#pragma unroll
        for (int j = 0; j < 64; ++j) { const unsigned long long bal = __ballot(u[j] >= T); if (lane == j) { mylo = (unsigned)bal; myhi = (unsigned)(bal >> 32); } }
        selbits[row0 * 64 + lane] = mylo; selbits[(row0 + 1) * 64 + lane] = myhi;
    }
}
constexpr int N_PHASES = 1 + 13 * DEPTH;
#ifndef PROBE_MASK
#define PROBE_MASK 0
#endif
__device__ __forceinline__ int probe_reps(int k) { int n = 1 + ((PROBE_MASK >> k) & 1); asm volatile("" : "+s"(n)); return n; }
__device__ __forceinline__ const void* karg_ptr(unsigned off) {
    asm volatile("" : "+s"(off));
    const __attribute__((address_space(4))) char* ka = (const __attribute__((address_space(4))) char*)__builtin_amdgcn_kernarg_segment_ptr();
    return *(const void* const __attribute__((address_space(4)))*)(ka + off);
}
#define KIN(i) ((const float*)karg_ptr(8u * (i)))
#define KOUT() ((float*)karg_ptr(168u))
#define KWS() ((unsigned char*)karg_ptr(176u))
static_assert(offsetof(Args, out) == 168 && offsetof(Args, ws) == 176 && offsetof(Args, ph_lo) == 184 && offsetof(Args, ph_hi) == 188 && sizeof(Args) == 192, "Args layout");
#define TIDS() int tid = threadIdx.x; asm volatile("" : "+v"(tid)); const int lane = tid & 63, wave = __builtin_amdgcn_readfirstlane(tid >> 6), gw = vcu * NWAVES + wave, ngw = G * NWAVES; (void)lane; (void)gw; (void)ngw
__global__ void __launch_bounds__(NWAVES * 64, 2) mega_fwd(Args args) {
    extern __shared__ __attribute__((aligned(16))) unsigned char lds[];
    LAS unsigned char* const ldsl = (LAS unsigned char*)lds;
    const int G = gridDim.x, bx = blockIdx.x, vcu = (G % 8 == 0) ? (bx % 8) * (G / 8) + bx / 8 : bx;
    { volatile LAS unsigned* const MISC0 = (volatile LAS unsigned*)(ldsl + LDSCTL_OFF);
      for (int u = threadIdx.x; u < (LDS_BYTES - LDSCTL_OFF) / 4; u += NWAVES * 64) MISC0[u] = 0u; }
    __syncthreads();
    XcdBarrier bar = xcd_barrier_post((unsigned*)((gu32*)(KWS() + WS_CTL) + CW_BAR), (volatile LAS unsigned*)(ldsl + MISC_OFF) + 8);
    int pc = 0; const int lo = args.ph_lo, hi = args.ph_hi;
#define RUN (pc >= lo && pc < hi)
#define PROBE_LOOP(k) for (int rep_ = 0, nrep_ = probe_reps(k); rep_ < nrep_; ++rep_)
#define SEAM() do { if (pc >= lo && pc + 1 < hi) xcd_barrier(bar); ++pc; } while (0)

    if (RUN) PROBE_LOOP(0) {
        TIDS(); unsigned char* const ws = KWS();
        LAS unsigned* scr = (LAS unsigned*)(ldsl + RING_OFF + wave * 16384);
        for (int mi = 0; mi < N_WMATS; ++mi) { const WDesc d = wdesc(ws, mi); const int nitems = (d.K / 64) * (d.Npad / 64);
            for (int it = gw; it < nitems; it += ngw) transpose_item(d, scr, it, lane); }
        cvt_rows(KIN(0), (bf16*)(ws + WS_XB), (size_t)T_TOK * DM, gw * 64 + lane, ngw * 64);
        cvt_rows(KIN(1), (bf16*)(ws + WS_PB), (size_t)DEPTH * T_TOK * PLE, gw * 64 + lane, ngw * 64);
    }
    SEAM();

    const int G0 = G, bx0 = bx, vcu0 = vcu; const XcdBarrier bar0 = bar;
    for (int hl = 0; hl < 2 * DEPTH; ++hl) {
        int G = G0, bx = bx0, vcu = vcu0; XcdBarrier bar = bar0;
        asm volatile("" : "+s"(G), "+s"(bx), "+s"(vcu), "+s"(bar.bar), "+s"(bar.x), "+s"(bar.st));
        const int layer = hl >> 1, second = hl & 1, mix = layer % 3, mj = layer / 3;
        if (RUN) PROBE_LOOP(1) {
            unsigned char* const ws = KWS(); unsigned char* const lw = ws + WS_W + (size_t)layer * LW_BYTES;
            pg8::Gemm g{(const bf16*)(ws + WS_XB), (const bf16*)(lw + (second ? LW_F2IN : LW_F1IN)), T_TOK, 2 * FF, DM}; pg8::StaticOrder S; S.init(T_TOK, 2 * FF, G, bx);
            pg8::EpiSwiGLU E{(bf16*)(ws + WS_H), FF};
            pg8::gemm_phase<pg8::EpiSwiGLU, pg8::StaticOrder, PG8_ALIGN, PG8_SP2>(ldsl + RING_OFF, g, S, E);
        }
        SEAM();
        if (RUN) PROBE_LOOP(2) {
            unsigned char* const ws = KWS(); unsigned char* const lw = ws + WS_W + (size_t)layer * LW_BYTES;
            const float* const resid0 = (hl == 0) ? KIN(0) : (const float*)(ws + WS_X);
            pg8::Gemm g{(const bf16*)(ws + WS_H), (const bf16*)(lw + (second ? LW_F2OUT : LW_F1OUT)), T_TOK, DM, FF}; pg8::StaticOrder S; S.init(T_TOK, DM, G, bx);
            pg8::EpiZ E{resid0, (float*)(ws + WS_Z), DM, ALPHA, 0.5f};
            pg8::gemm_phase<pg8::EpiZ, pg8::StaticOrder, PG8_ALIGN, PG8_SP2>(ldsl + RING_OFF, g, S, E);
        }
        SEAM();
        if (RUN) PROBE_LOOP(3) { TIDS(); unsigned char* const ws = KWS(); const size_t lo_ = ((size_t)layer * 4 + (second ? 2 : 0)) * DM;
            ln_phase((const float*)(ws + WS_Z), KIN(6) + lo_, KIN(7) + lo_, (float*)(ws + WS_X), (bf16*)(ws + WS_XB), gw, ngw, lane); }
        SEAM();
        if (!second) {
            const int n_in = (mix == 2) ? NC_IN_PAD : NA_IN;
            if (RUN) PROBE_LOOP(4) {
                unsigned char* const ws = KWS(); unsigned char* const mb = ws + WS_MIX;
                const bf16* const w_in = (const bf16*)(mix == 0 ? mb + (size_t)mj * MW_A_STRIDE + MW_A_IN : mix == 1 ? mb + MW_B_IN : mb + MW_C_IN);
                { pg8::Gemm g{(const bf16*)(ws + WS_XB), w_in, T_TOK, n_in, DM}; pg8::StaticOrder S; S.init(T_TOK, n_in, G, bx);
                  pg8::EpiBf16<0> E{(bf16*)(ws + WS_QKV), n_in, nullptr, 0, 0, 1.f};
                  pg8::gemm_phase<pg8::EpiBf16<0>, pg8::StaticOrder, PG8_ALIGN, PG8_SP2>(ldsl + RING_OFF, g, S, E); }
                { pg8::Gemm g{(const bf16*)(ws + WS_PB) + (size_t)layer * T_TOK * PLE, (const bf16*)(ws + WS_W + (size_t)layer * LW_BYTES + LW_PP), T_TOK, DM, PLE}; pg8::StaticOrder S; S.init(T_TOK, DM, G, bx);
                  pg8::EpiF32 E{(float*)(ws + WS_PP), DM};
                  pg8::gemm_phase<pg8::EpiF32, pg8::StaticOrder, PG8_ALIGN, PG8_SP2>(ldsl + RING_OFF, g, S, E); }
            }
            SEAM();
            if (mix == 0) {
                if (RUN) PROBE_LOOP(5) { unsigned char* const ws = KWS();
                    att::attn_phase<0>((char*)lds + RING_OFF, (const bf16*)(ws + WS_QKV), NA_IN, (bf16*)(ws + WS_OP), 4096, ws + WS_RM, (const unsigned*)(ws + WS_SEL), 32, bx, G); }
                SEAM();
                if (RUN) PROBE_LOOP(6) { TIDS(); unsigned char* const ws = KWS();
                    diff_combine_phase((const bf16*)(ws + WS_OP), (bf16*)(ws + WS_AO), KIN(12) + mj * 128, KIN(13) + mj * 128, KIN(14) + mj * 128, KIN(15) + mj * 128, KIN(16) + mj * 256,
                                       0.8f - 0.6f * expf(-0.3f * (float)layer), gw, ngw, lane); }
                SEAM();
            } else if (mix == 1) {
                if (RUN) PROBE_LOOP(6) { TIDS(); unsigned char* const ws = KWS(); moba_gate_phase((const bf16*)(ws + WS_QKV), ws + WS_RM, ldsl + RING_OFF, vcu, G, tid); }
                SEAM();
                if (RUN) PROBE_LOOP(5) { unsigned char* const ws = KWS();
                    att::attn_phase<1>((char*)lds + RING_OFF, (const bf16*)(ws + WS_QKV), NA_IN, (bf16*)(ws + WS_AO), DM, ws + WS_RM, (const unsigned*)(ws + WS_SEL), 16, bx, G); }
                SEAM();
            } else {
                if (RUN) PROBE_LOOP(6) { TIDS(); unsigned char* const ws = KWS(); dsa_index_phase((const bf16*)(ws + WS_QKV), (unsigned*)(ws + WS_SEL), gw, ngw, lane); }
                SEAM();
                if (RUN) PROBE_LOOP(5) { unsigned char* const ws = KWS();
                    att::attn_phase<2>((char*)lds + RING_OFF, (const bf16*)(ws + WS_QKV), NC_IN_PAD, (bf16*)(ws + WS_AO), DM, ws + WS_RM, (const unsigned*)(ws + WS_SEL), 16, bx, G); }
                SEAM();
            }
            if (RUN) PROBE_LOOP(7) {
                unsigned char* const ws = KWS(); unsigned char* const mb = ws + WS_MIX;
                const bf16* const w_out = (const bf16*)(mix == 0 ? mb + (size_t)mj * MW_A_STRIDE + MW_A_OUT : mix == 1 ? mb + MW_B_OUT : mb + MW_C_OUT);
                pg8::Gemm g{(const bf16*)(ws + WS_AO), w_out, T_TOK, DM, DM}; pg8::StaticOrder S; S.init(T_TOK, DM, G, bx);
                pg8::EpiZ E{(const float*)(ws + WS_X), (float*)(ws + WS_Z), DM, ALPHA, 1.0f};
                pg8::gemm_phase<pg8::EpiZ, pg8::StaticOrder, PG8_ALIGN, PG8_SP2>(ldsl + RING_OFF, g, S, E);
            }
            SEAM();
            if (RUN) PROBE_LOOP(3) { TIDS(); unsigned char* const ws = KWS(); const size_t lo_ = ((size_t)layer * 4 + 1) * DM;
                ln_phase((const float*)(ws + WS_Z), KIN(6) + lo_, KIN(7) + lo_, (float*)(ws + WS_X), (bf16*)(ws + WS_XB), gw, ngw, lane); }
            SEAM();
        } else {
            if (RUN) PROBE_LOOP(8) {
                unsigned char* const ws = KWS();
                pg8::Gemm g{(const bf16*)(ws + WS_XB), (const bf16*)(ws + WS_W + (size_t)layer * LW_BYTES + LW_PG), T_TOK, DM, DM}; pg8::StaticOrder S; S.init(T_TOK, DM, G, bx);
                pg8::EpiPle E{(const float*)(ws + WS_X), (const float*)(ws + WS_PP), (float*)(ws + WS_Z), DM, ALPHA};
                pg8::gemm_phase<pg8::EpiPle, pg8::StaticOrder, PG8_ALIGN, PG8_SP2>(ldsl + RING_OFF, g, S, E);
            }
            SEAM();
            if (RUN) PROBE_LOOP(3) { TIDS(); unsigned char* const ws = KWS(); const size_t lo_ = ((size_t)layer * 4 + 3) * DM; const bool fin = layer == DEPTH - 1;
                ln_phase((const float*)(ws + WS_Z), KIN(6) + lo_, KIN(7) + lo_, fin ? KOUT() : (float*)(ws + WS_X), fin ? (bf16*)nullptr : (bf16*)(ws + WS_XB), gw, ngw, lane); }
            SEAM();
        }
    }
#undef RUN
#undef SEAM
}

extern "C" void kernel_launch(void* const* d_in, const int* in_sizes, int n_in, void* d_out, int out_size, void* d_ws, size_t ws_size, hipStream_t stream) {
    static int grid = 0;
    if (grid == 0) {
        if (n_in != 21 || in_sizes[0] != T_TOK * DM || out_size != T_TOK * DM || ws_size < WS_END) {
            fprintf(stderr, "kernel_launch: shape/workspace mismatch (n_in %d, in0 %d, out %d, ws %zu, need %zu); nothing launched\n", n_in, n_in > 0 ? in_sizes[0] : -1, out_size, ws_size, (size_t)WS_END); grid = -1; return; }
        int dev = 0, cus = 0, per_cu = 0;
        if (hipGetDevice(&dev) != hipSuccess || hipDeviceGetAttribute(&cus, hipDeviceAttributeMultiprocessorCount, dev) != hipSuccess) { fprintf(stderr, "kernel_launch: device query failed\n"); grid = -1; return; }
        if (hipFuncSetAttribute((const void*)mega_fwd, hipFuncAttributeMaxDynamicSharedMemorySize, LDS_BYTES) != hipSuccess) { fprintf(stderr, "kernel_launch: hipFuncSetAttribute failed\n"); grid = -1; return; }
        if (hipOccupancyMaxActiveBlocksPerMultiprocessor(&per_cu, (const void*)mega_fwd, NWAVES * 64, LDS_BYTES) != hipSuccess || per_cu < 1)
            fprintf(stderr, "kernel_launch: note: occupancy query reports %d workgroups per CU\n", per_cu);
        (void)hipGetLastError();
        grid = cus;
    }
    if (grid < 0) return;
    if (hipMemsetAsync((char*)d_ws + WS_CTL, 0, CTL_ZERO_BYTES, stream) != hipSuccess) { fprintf(stderr, "kernel_launch: memset failed\n"); return; }
    Args a{};
    for (int i = 0; i < 21; ++i) a.in[i] = (const float*)d_in[i];
    a.out = (float*)d_out; a.ws = (unsigned char*)d_ws;
#if MK_PER_PHASE
    for (int p = 0; p < N_PHASES; ++p) { a.ph_lo = p; a.ph_hi = p + 1; hipLaunchKernelGGL(mega_fwd, dim3(grid), dim3(NWAVES * 64), LDS_BYTES, stream, a); }
#else
    a.ph_lo = 0; a.ph_hi = N_PHASES;
    hipLaunchKernelGGL(mega_fwd, dim3(grid), dim3(NWAVES * 64), LDS_BYTES, stream, a);
#endif
    const hipError_t le = hipPeekAtLastError();
    if (le != hipSuccess) fprintf(stderr, "kernel_launch: launch failed: %s\n", hipGetErrorName(le));
}
```
